# Optimizing an MI355X kernel written in HIP

```python
import math
import jax
import jax.numpy as jnp
from jax import lax
import numpy as np

D_MODEL = 1024
BATCH = 2
SEQ = 8192
DEPTH = 2

HEAD_DIM = 64
N_HEADS = D_MODEL // HEAD_DIM
A_HEADS = N_HEADS // 2
B_HEADS = N_HEADS - A_HEADS
B_KV_HEADS = max(1, B_HEADS // 4)
C_HEADS = N_HEADS
C_KV_HEADS = max(1, C_HEADS // 4)
MIX_WIDTH = N_HEADS * HEAD_DIM
A_PATTERNS = ((128, 1), (512, 4), (2048, 16))
A_BLOCK = 64
B_WINDOW = 128
B_BLOCK = 128
C_BLOCK = 128
GRID_W = 64
ROPE_THETA = 10000.0
ROPE_AXIS_DIM = HEAD_DIM // 2
ALIBI_MAX_BIAS = 8.0
RMS_EPS = 1e-6
MOE_GROUPS = 4
MOE_EXPERTS = 8
MOE_TOP_K = 2
MOE_D_FF = D_MODEL // 4
A_W = A_HEADS * HEAD_DIM
B_QW = B_HEADS * HEAD_DIM
B_KVW = B_KV_HEADS * HEAD_DIM
AB_SPLITS = (A_W, 2 * A_W, 3 * A_W, 3 * A_W + B_QW, 3 * A_W + B_QW + B_KVW)
AB_PROJ = 3 * A_W + B_QW + 2 * B_KVW
C_QW = C_HEADS * HEAD_DIM
C_KVW = C_KV_HEADS * HEAD_DIM
C_SPLITS = (C_QW, C_QW + C_KVW)
C_PROJ = C_QW + 2 * C_KVW
N_EVEN = (DEPTH + 1) // 2
N_ODD = DEPTH // 2

kernel_name = 'hybrid_dilated_window_axial_hmoe'


def _rmsnorm(x, g):
    x32 = x.astype(jnp.float32)
    y = x32 * lax.rsqrt(jnp.mean(x32 * x32, axis=-1, keepdims=True) + RMS_EPS)
    return (y * g.astype(jnp.float32)).astype(x.dtype)


def _alibi_slopes(n):
    return jnp.asarray(2.0 ** (-ALIBI_MAX_BIAS * np.arange(1, n + 1) / n), dtype=jnp.float32)


def _banded_attention(q, k, v, half_window, block, dist_scale, slopes, sink=None):
    b, L, H, hd = q.shape
    hkv = k.shape[2]
    grp = H // hkv
    nblk = -(-L // block)
    lp = nblk * block
    kw = block + 2 * half_window
    qp = jnp.pad(q, ((0, 0), (0, lp - L), (0, 0), (0, 0)))
    pad_k = ((0, 0), (half_window, lp - L + half_window), (0, 0), (0, 0))
    kp = jnp.pad(k, pad_k)
    vp = jnp.pad(v, pad_k)
    key_idx = np.arange(nblk)[:, None] * block + np.arange(kw)[None, :]
    kb = kp[:, key_idx]
    vb = vp[:, key_idx]
    qb = qp.reshape(b, nblk, block, hkv, grp, hd)
    s = jnp.einsum('bnqkgd,bnskd->bnkgqs', qb, kb, preferred_element_type=jnp.float32) * (hd ** -0.5)
    qpos = np.arange(nblk)[:, None] * block + np.arange(block)[None, :]
    kpos = key_idx - half_window
    rel = np.abs(kpos[:, None, :] - qpos[:, :, None])
    valid = (rel <= half_window) & (kpos[:, None, :] >= 0) & (kpos[:, None, :] < L)
    dist = jnp.asarray(rel, dtype=jnp.float32) * dist_scale
    slopes_kg = slopes.reshape(hkv, grp)
    s = s - slopes_kg[None, None, :, :, None, None] * dist[None, :, None, None, :, :]
    s = jnp.where(valid[None, :, None, None], s, -jnp.inf)
    m = jnp.max(s, axis=-1, keepdims=True)
    if sink is not None:
        sink_b = sink.astype(jnp.float32).reshape(hkv, grp)[None, None, :, :, None, None]
        m = jnp.maximum(m, sink_b)
    p = jnp.exp(s - m)
    l = jnp.sum(p, axis=-1, keepdims=True)
    if sink is not None:
        l = l + jnp.exp(sink_b - m)
    o = jnp.einsum('bnkgqs,bnskd->bnqkgd', p.astype(v.dtype), vb, preferred_element_type=jnp.float32)
    o = o / jnp.moveaxis(l[..., 0], -1, 2)[..., None]
    lse = jnp.moveaxis((m + jnp.log(l))[..., 0], -1, 2)
    o = o.reshape(b, lp, H, hd)[:, :L]
    lse = lse.reshape(b, lp, H)[:, :L]
    return o, lse


def _to_strided(t, dil):
    b, S, h, hd = t.shape
    return t.reshape(b, S // dil, dil, h, hd).transpose(0, 2, 1, 3, 4).reshape(b * dil, S // dil, h, hd)


def _from_strided(t, b, dil):
    bd, L = t.shape[0], t.shape[1]
    rest = t.shape[2:]
    t = t.reshape((b, dil, L) + rest)
    t = jnp.moveaxis(t, 1, 2)
    return t.reshape((b, L * dil) + rest)


def _dilated_mixture(q, k, v, slopes):
    b = q.shape[0]
    outs, lses = [], []
    for window, dil in A_PATTERNS:
        half = (window // 2) // dil
        o, lse = _banded_attention(_to_strided(q, dil), _to_strided(k, dil), _to_strided(v, dil),
                                   half, A_BLOCK, float(dil), slopes)
        outs.append(_from_strided(o, b, dil))
        lses.append(_from_strided(lse, b, dil))
    w = jax.nn.softmax(jnp.stack(lses, axis=0), axis=0)
    return jnp.sum(w[..., None] * jnp.stack(outs, axis=0), axis=0)


def _mixer_ab(h, w_in, a_qn, a_kn, b_qn, b_kn, b_sink, w_out):
    b, S, _ = h.shape
    proj = jnp.einsum('bsd,de->bse', h, w_in)
    qa, ka, va, qb, kb, vb = jnp.split(proj, AB_SPLITS, axis=-1)
    qa = _rmsnorm(qa.reshape(b, S, A_HEADS, HEAD_DIM), a_qn)
    ka = _rmsnorm(ka.reshape(b, S, A_HEADS, HEAD_DIM), a_kn)
    va = va.reshape(b, S, A_HEADS, HEAD_DIM)
    qb = _rmsnorm(qb.reshape(b, S, B_HEADS, HEAD_DIM), b_qn)
    kb = _rmsnorm(kb.reshape(b, S, B_KV_HEADS, HEAD_DIM), b_kn)
    vb = vb.reshape(b, S, B_KV_HEADS, HEAD_DIM)
    slopes = _alibi_slopes(A_HEADS + B_HEADS)
    oa = _dilated_mixture(qa, ka, va, slopes[0::2])
    ob, _ = _banded_attention(qb, kb, vb, B_WINDOW, B_BLOCK, 1.0, slopes[1::2], sink=b_sink)
    o = jnp.concatenate([oa.reshape(b, S, A_W), ob.reshape(b, S, B_QW)], axis=-1).astype(h.dtype)
    return jnp.einsum('bse,ed->bsd', o, w_out)


def _axial_rope_tables(seq_len):
    rows = seq_len // GRID_W
    row = jnp.broadcast_to(jnp.arange(rows, dtype=jnp.float32)[:, None], (rows, GRID_W)).reshape(-1)
    col = jnp.broadcast_to(jnp.arange(GRID_W, dtype=jnp.float32)[None, :], (rows, GRID_W)).reshape(-1)
    inv_freq = ROPE_THETA ** (-jnp.arange(0, ROPE_AXIS_DIM, 2, dtype=jnp.float32) / ROPE_AXIS_DIM)
    ang_r = row[:, None] * inv_freq[None, :]
    ang_c = col[:, None] * inv_freq[None, :]
    return jnp.cos(ang_r), jnp.sin(ang_r), jnp.cos(ang_c), jnp.sin(ang_c)


def _rotate(t, cos, sin):
    half = t.shape[-1] // 2
    t1, t2 = t[..., :half], t[..., half:]
    c = cos[None, :, None, :]
    s = sin[None, :, None, :]
    return jnp.concatenate([t1 * c - t2 * s, t2 * c + t1 * s], axis=-1)


def _apply_axial_rope(x, cr, sr, cc, sc):
    x32 = x.astype(jnp.float32)
    out = jnp.concatenate([_rotate(x32[..., :ROPE_AXIS_DIM], cr, sr),
                           _rotate(x32[..., ROPE_AXIS_DIM:], cc, sc)], axis=-1)
    return out.astype(x.dtype)


def _dense_blocked_attention(q, k, v):
    b, S, H, hd = q.shape
    hkv = k.shape[2]
    grp = H // hkv
    nq = S // C_BLOCK
    qb = q.reshape(b, nq, C_BLOCK, hkv, grp, hd).transpose(1, 0, 2, 3, 4, 5)

    def one_block(qblk):
        s = jnp.einsum('bqkgd,bskd->bkgqs', qblk, k, preferred_element_type=jnp.float32) * (hd ** -0.5)
        p = jax.nn.softmax(s, axis=-1)
        o = jnp.einsum('bkgqs,bskd->bqkgd', p.astype(v.dtype), v, preferred_element_type=jnp.float32)
        return o.astype(q.dtype)

    o = lax.map(one_block, qb)
    return o.transpose(1, 0, 2, 3, 4, 5).reshape(b, S, H, hd)


def _mixer_c(h, w_in, qn, kn, w_out):
    b, S, _ = h.shape
    proj = jnp.einsum('bsd,de->bse', h, w_in)
    q, k, v = jnp.split(proj, C_SPLITS, axis=-1)
    q = _rmsnorm(q.reshape(b, S, C_HEADS, HEAD_DIM), qn)
    k = _rmsnorm(k.reshape(b, S, C_KV_HEADS, HEAD_DIM), kn)
    v = v.reshape(b, S, C_KV_HEADS, HEAD_DIM)
    cr, sr, cc, sc = _axial_rope_tables(S)
    q = _apply_axial_rope(q, cr, sr, cc, sc)
    k = _apply_axial_rope(k, cr, sr, cc, sc)
    o = _dense_blocked_attention(q, k, v).reshape(b, S, C_QW)
    return jnp.einsum('bse,ed->bsd', o, w_out)


def _hier_moe(h, wg, bg, we, be, w_gate, w_up, w_down):
    b, S, d = h.shape
    xt = h.reshape(b * S, d)
    pg = jax.nn.softmax(jnp.einsum('nd,dg->ng', xt, wg, preferred_element_type=jnp.float32)
                        + bg.astype(jnp.float32), axis=-1)
    g_idx = jnp.argmax(pg, axis=-1)
    onehot_g = jax.nn.one_hot(g_idx, MOE_GROUPS, dtype=jnp.float32)
    p_grp = jnp.sum(pg * onehot_g, axis=-1)
    logits_e = jnp.einsum('nd,gde->nge', xt, we, preferred_element_type=jnp.float32) + be.astype(jnp.float32)[None]
    sel = jnp.einsum('nge,ng->ne', logits_e, onehot_g)
    pe = jax.nn.softmax(sel, axis=-1)
    top_p, top_i = lax.top_k(pe, MOE_TOP_K)
    top_p = top_p / jnp.sum(top_p, axis=-1, keepdims=True)
    w_e = jnp.sum(top_p[..., None] * jax.nn.one_hot(top_i, MOE_EXPERTS, dtype=jnp.float32), axis=1)
    comb = p_grp[:, None, None] * onehot_g[:, :, None] * w_e[:, None, :]
    y = jnp.zeros((b * S, d), jnp.float32)
    for g in range(MOE_GROUPS):
        a = jnp.einsum('nd,edf->nef', xt, w_gate[g], preferred_element_type=jnp.float32)
        u = jnp.einsum('nd,edf->nef', xt, w_up[g], preferred_element_type=jnp.float32)
        act = jax.nn.silu(a) * u * comb[:, g, :, None]
        y = y + jnp.einsum('nef,efd->nd', act.astype(xt.dtype), w_down[g], preferred_element_type=jnp.float32)
    return y.reshape(b, S, d).astype(h.dtype)


def setup_inputs(seed: int = 0) -> dict:
    key = jax.random.key(seed)
    ks = jax.random.split(key, 21)

    def nrm(k, shape, scale):
        return jax.random.normal(k, shape, jnp.float32) * scale

    def gain(k, shape):
        return 1.0 + 0.02 * jax.random.normal(k, shape, jnp.float32)

    return {
        'x': nrm(ks[0], (BATCH, SEQ, D_MODEL), 1.0),
        'mix_norm': gain(ks[1], (DEPTH, D_MODEL)),
        'ffn_norm': gain(ks[2], (DEPTH, D_MODEL)),
        'ab_w_in': nrm(ks[3], (N_EVEN, D_MODEL, AB_PROJ), D_MODEL ** -0.5),
        'a_q_norm': gain(ks[4], (N_EVEN, HEAD_DIM)),
        'a_k_norm': gain(ks[5], (N_EVEN, HEAD_DIM)),
        'b_q_norm': gain(ks[6], (N_EVEN, HEAD_DIM)),
        'b_k_norm': gain(ks[7], (N_EVEN, HEAD_DIM)),
        'b_sink': nrm(ks[8], (N_EVEN, B_HEADS), 0.5),
        'ab_w_out': nrm(ks[9], (N_EVEN, MIX_WIDTH, D_MODEL), MIX_WIDTH ** -0.5),
        'c_w_in': nrm(ks[10], (N_ODD, D_MODEL, C_PROJ), D_MODEL ** -0.5),
        'c_q_norm': gain(ks[11], (N_ODD, HEAD_DIM)),
        'c_k_norm': gain(ks[12], (N_ODD, HEAD_DIM)),
        'c_w_out': nrm(ks[13], (N_ODD, C_QW, D_MODEL), C_QW ** -0.5),
        'moe_group_w': nrm(ks[14], (DEPTH, D_MODEL, MOE_GROUPS), D_MODEL ** -0.5),
        'moe_group_b': nrm(ks[15], (DEPTH, MOE_GROUPS), 0.01),
        'moe_expert_w': nrm(ks[16], (DEPTH, MOE_GROUPS, D_MODEL, MOE_EXPERTS), D_MODEL ** -0.5),
        'moe_expert_b': nrm(ks[17], (DEPTH, MOE_GROUPS, MOE_EXPERTS), 0.01),
        'moe_w_gate': nrm(ks[18], (DEPTH, MOE_GROUPS, MOE_EXPERTS, D_MODEL, MOE_D_FF), D_MODEL ** -0.5),
        'moe_w_up': nrm(ks[19], (DEPTH, MOE_GROUPS, MOE_EXPERTS, D_MODEL, MOE_D_FF), D_MODEL ** -0.5),
        'moe_w_down': nrm(ks[20], (DEPTH, MOE_GROUPS, MOE_EXPERTS, MOE_D_FF, D_MODEL), MOE_D_FF ** -0.5),
    }


def reference(x, mix_norm, ffn_norm, ab_w_in, a_q_norm, a_k_norm, b_q_norm, b_k_norm, b_sink, ab_w_out,
              c_w_in, c_q_norm, c_k_norm, c_w_out, moe_group_w, moe_group_b, moe_expert_w, moe_expert_b,
              moe_w_gate, moe_w_up, moe_w_down):
    for layer in range(DEPTH):
        i = layer // 2
        h = _rmsnorm(x, mix_norm[layer])
        if layer % 2 == 0:
            x = x + _mixer_ab(h, ab_w_in[i], a_q_norm[i], a_k_norm[i], b_q_norm[i], b_k_norm[i],
                              b_sink[i], ab_w_out[i])
        else:
            x = x + _mixer_c(h, c_w_in[i], c_q_norm[i], c_k_norm[i], c_w_out[i])
        h = _rmsnorm(x, ffn_norm[layer])
        x = x + _hier_moe(h, moe_group_w[layer], moe_group_b[layer], moe_expert_w[layer], moe_expert_b[layer],
                          moe_w_gate[layer], moe_w_up[layer], moe_w_down[layer])
    return x
```

```cpp
#include <hip/hip_runtime.h>
#include <hip/hip_bf16.h>
#include <cstdio>
#include <cstdint>
#include <cmath>
#define MK_N_LAUNCHES 0
#define NAIVE_MOE 0
#define DBG_SCALE 1.0f
namespace pg8 {
#define PG8_LAS __attribute__((address_space(3)))
typedef unsigned short bf16_t;
typedef short bf16x8 __attribute__((ext_vector_type(8)));
typedef float f32x4 __attribute__((ext_vector_type(4)));
typedef unsigned u32x4 __attribute__((ext_vector_type(4)));
constexpr int BM = 256, BK = 64, HALF = 128, HTB = HALF * BK * 2  , STAGE_BYTES = 8 * HTB, NXCD = 8, WGM = 8;

__host__ __device__ __forceinline__ int lds_byte(int r, int c) { const int st = (r >> 4) * 2 + (c >> 5), rr = r & 15, cc = c & 31, ob = rr * 64 + cc * 2; return st * 1024 + (ob ^ (((ob >> 9) & 1) << 5)); }
__host__ __device__ __forceinline__ void stage_rc(int b, int& R, int& C) { const int st = b / 1024, sb = b % 1024, swz = sb ^ (((sb >> 9) & 1) << 5); R = (st >> 1) * 16 + swz / 64; C = (st & 1) * 32 + (swz % 64) / 2; }
__host__ __device__ __forceinline__ int perm32(int rho) { const int n = rho >> 4, i = rho & 15; return 8 * (i >> 2) + 4 * n + (i & 3); }

struct Unit { int pm, pn; };
struct Gemm { const bf16_t* A; const bf16_t* Bt; int M, N, K; };

struct StaticOrder {
    int nM, nN, nwg, G, c;
    __host__ __device__ void init(int M, int N, int G_, int c_) { nM = M / BM; nN = N / BM; nwg = nM * nN; G = G_; c = c_; }
    __host__ __device__ bool next(int i, Unit& u) const {
        const long L = (long)i * G + c; if (L >= nwg) return false;
        int wgid = (int)L; { const int q = nwg / NXCD, r = nwg % NXCD, xcd = wgid % NXCD, off = wgid / NXCD; wgid = (xcd < r ? xcd * (q + 1) : r * (q + 1) + (xcd - r) * q) + off; }
        const int nig = WGM * nN, gid = wgid / nig, fm = gid * WGM, gsz = (nM - fm) < WGM ? (nM - fm) : WGM;
        u.pm = fm + ((wgid % nig) % gsz); u.pn = (wgid % nig) / gsz; return true;
    }
    __device__ __forceinline__ void a_ready(const Unit&) const {}
    __device__ __forceinline__ void done(const Unit&) const {}
};

__device__ __forceinline__ unsigned cvt_pk_bf16(float lo, float hi) { unsigned r; asm volatile("v_cvt_pk_bf16_f32 %0, %1, %2" : "=v"(r) : "v"(lo), "v"(hi)); return r; }
typedef float f32x2 __attribute__((ext_vector_type(2)));
struct DstTile { bf16_t* p; int ldc; int c0; };
template <unsigned oq, unsigned oka, unsigned ova, unsigned okvb> struct ResL0T { unsigned char* ws;
    __device__ __forceinline__ DstTile operator()(int pn) const {
        unsigned off = okvb; int ldc = 256, c0 = 0;
        if (pn < 2) { off = oq; ldc = 1024; c0 = 256 * pn; }
        else if (pn < 4) { off = oka; ldc = 512; c0 = 256 * (pn - 2); }
        else if (pn < 6) { off = ova; ldc = 512; c0 = 256 * (pn - 4); }
        else if (pn < 8) { off = oq; ldc = 1024; c0 = 512 + 256 * (pn - 6); }
        return DstTile{(bf16_t*)(ws + off), ldc, c0}; } };
template <unsigned oq, unsigned ok, unsigned ov> struct ResL1T { unsigned char* ws;
    __device__ __forceinline__ DstTile operator()(int pn) const {
        unsigned off = ov; int ldc = 256, c0 = 0;
        if (pn < 4) { off = oq; ldc = 1024; c0 = 256 * pn; }
        else if (pn == 4) { off = ok; }
        return DstTile{(bf16_t*)(ws + off), ldc, c0}; } };
struct ResY { bf16_t* y;
    __device__ __forceinline__ DstTile operator()(int pn) const { return DstTile{y, 1024, 256 * (pn & 3)}; } };

template <class R> struct EpiBf16Dst {
    static constexpr bool PERM = true, AFTER_DRAIN = false;
    R res;
    __device__ __forceinline__ void operator()(const f32x4 (&acc)[2][2][4][2], const Unit& u, int wr, int wc, int fr, int fq) const {
        asm volatile("" : "+v"(fr), "+v"(fq));
        const DstTile d = res(u.pn);
        const int row0 = u.pm * BM + wr * 64 + fr; const int col0 = d.c0 + wc * 32 + 8 * fq;
#pragma unroll
        for (int ai = 0; ai < 2; ++ai)
#pragma unroll
            for (int m = 0; m < 4; ++m) { bf16_t* rowp = d.p + (size_t)(row0 + ai * HALF + m * 16) * d.ldc + col0;
#pragma unroll
                for (int bj = 0; bj < 2; ++bj) { const f32x4 v0 = acc[ai][bj][m][0], v1 = acc[ai][bj][m][1];
                    u32x4 w; w.x = cvt_pk_bf16(v0[0], v0[1]); w.y = cvt_pk_bf16(v0[2], v0[3]); w.z = cvt_pk_bf16(v1[0], v1[1]); w.w = cvt_pk_bf16(v1[2], v1[3]);
                    *(u32x4*)(rowp + bj * HALF) = w; } }
    }
};
struct EpiResid {
    static constexpr bool PERM = false, AFTER_DRAIN = false;
    const float* base; float* out; int ldc;
    __device__ __forceinline__ void operator()(const f32x4 (&acc)[2][2][4][2], const Unit& u, int wr, int wc, int fr, int fq) const {
        asm volatile("" : "+v"(fr), "+v"(fq));
        const int col0 = u.pn * BM + wc * 32 + 4 * fq;
#pragma unroll
        for (int ai = 0; ai < 2; ++ai)
#pragma unroll
            for (int m = 0; m < 4; ++m) { const size_t off = (size_t)(u.pm * BM + ai * HALF + wr * 64 + m * 16 + fr) * ldc + col0;
#pragma unroll
                for (int bj = 0; bj < 2; ++bj)
#pragma unroll
                    for (int n = 0; n < 2; ++n) { const f32x4 b = *(const f32x4*)(base + off + bj * HALF + n * 16); *(f32x4*)(out + off + bj * HALF + n * 16) = b + acc[ai][bj][m][n]; }
                asm volatile("" ::: "memory"); }
    }
};
__device__ __forceinline__ float silu_f(float a) { return a * __builtin_amdgcn_rcpf(1.0f + __builtin_amdgcn_exp2f(-1.4426950408889634f * a)); }
struct EpiSwiGLU {
    static constexpr bool PERM = true, AFTER_DRAIN = false;
    bf16_t* A2; const float* slot_w;
    __device__ __forceinline__ void operator()(const f32x4 (&acc)[2][2][4][2], const Unit& u, int wr, int wc, int fr, int fq) const {
        asm volatile("" : "+v"(fr), "+v"(fq));
        const int j = u.pn & 1; const int row0 = u.pm * BM + wr * 64 + fr; const int col0 = j * 128 + wc * 32 + 8 * fq;
#pragma unroll
        for (int ai = 0; ai < 2; ++ai)
#pragma unroll
            for (int m = 0; m < 4; ++m) { const int row = row0 + ai * HALF + m * 16; const float w = slot_w[row];
                const f32x4 g0 = acc[ai][0][m][0], g1 = acc[ai][0][m][1], u0 = acc[ai][1][m][0], u1 = acc[ai][1][m][1];
                u32x4 o;
                o.x = cvt_pk_bf16(silu_f(g0[0]) * u0[0] * w, silu_f(g0[1]) * u0[1] * w); o.y = cvt_pk_bf16(silu_f(g0[2]) * u0[2] * w, silu_f(g0[3]) * u0[3] * w);
                o.z = cvt_pk_bf16(silu_f(g1[0]) * u1[0] * w, silu_f(g1[1]) * u1[1] * w); o.w = cvt_pk_bf16(silu_f(g1[2]) * u1[2] * w, silu_f(g1[3]) * u1[3] * w);
                *(u32x4*)(A2 + (size_t)row * 256 + col0) = o; }
    }
};
template <int NJ> struct MoeOrder {
    const PG8_LAS int* tab; int G, c;
    __device__ __forceinline__ bool next(int i, Unit& u) const {
        const int total = __builtin_amdgcn_readfirstlane(tab[0]) * NJ; const int L = i * G + c; if (L >= total) return false;
        const int tile = L / NJ, j = L - tile * NJ;
        u.pm = tile; u.pn = __builtin_amdgcn_readfirstlane(tab[1 + tile]) * NJ + j; return true;
    }
    __device__ __forceinline__ void a_ready(const Unit&) const {}
    __device__ __forceinline__ void done(const Unit&) const {}
};
template <class Epi, class Sched, bool ALIGN_EPI = false, bool SP2 = false>
__device__ __forceinline__ void gemm_phase(PG8_LAS unsigned char* lds, const Gemm g, const Sched& S, const Epi& E, const int tid_in) {
    int tid_ = tid_in; asm volatile("" : "+v"(tid_));
    const int tid = tid_, wid = __builtin_amdgcn_readfirstlane(tid >> 6), lane = tid & 63, wr = wid >> 2, wc = wid & 3, fr = lane & 15, fq = lane >> 4;
    const int K = g.K, nt = K / BK;
    unsigned voffA[2], voffB[2];
#pragma unroll
    for (int i = 0; i < 2; ++i) { int R, C; stage_rc(tid * 16 + i * 8192, R, C); const int Rb = Epi::PERM ? ((R & ~31) + perm32(R & 31)) : R;
        voffA[i] = (unsigned)(R * K + C) * 2u; voffB[i] = (unsigned)(Rb * K + C) * 2u; }
    const size_t kstep = (size_t)(BK * 2);
    const size_t hstep = (size_t)HALF * K * 2;
    const size_t tstep = 2 * hstep;
    const unsigned ldsw = (unsigned)wid * 1024u;
    const int aoff = lds_byte(wr * 64 + fr, fq * 8), boff = lds_byte(wc * 32 + fr, fq * 8);
#define PG8_SA(b, h) (((b) * 2 + (h)) * HTB)
#define PG8_SB(b, h) ((4 + (b) * 2 + (h)) * HTB)
#define PG8_STAGE(bufoff, gbase, voff) do { _Pragma("unroll") for (int _i = 0; _i < 2; ++_i) \
        __builtin_amdgcn_global_load_lds((const unsigned*)((const char*)(gbase) + (voff)[_i]), (PG8_LAS unsigned*)(lds + (bufoff) + ldsw + _i * 8192), 16, 0, 0); } while (0)
#define PG8_LDA(dst, b, h) do { _Pragma("unroll") for (int m = 0; m < 4; ++m) _Pragma("unroll") for (int k = 0; k < 2; ++k) dst[m][k] = *(const PG8_LAS bf16x8*)(lds + PG8_SA(b, h) + aoff + m * 2048 + k * 1024); } while (0)
#define PG8_LDB(dst, b, h) do { _Pragma("unroll") for (int n = 0; n < 2; ++n) _Pragma("unroll") for (int k = 0; k < 2; ++k) dst[n][k] = *(const PG8_LAS bf16x8*)(lds + PG8_SB(b, h) + boff + n * 2048 + k * 1024); } while (0)
#define PG8_MMA(ai, bj, At, Bt) do { __builtin_amdgcn_s_setprio(1); _Pragma("unroll") for (int m = 0; m < 4; ++m) _Pragma("unroll") for (int n = 0; n < 2; ++n) _Pragma("unroll") for (int k = 0; k < 2; ++k) \
        acc[ai][bj][m][n] = __builtin_amdgcn_mfma_f32_16x16x32_bf16(Bt[n][k], At[m][k], acc[ai][bj][m][n], 0, 0, 0); __builtin_amdgcn_s_setprio(0); } while (0)
#define PG8_WAIT_V(n) asm volatile("s_waitcnt vmcnt(" #n ")" ::: "memory")
#define PG8_WAIT_L(n) asm volatile("s_waitcnt lgkmcnt(" #n ")" ::: "memory")
#define PG8_BAR __builtin_amdgcn_s_barrier()
#define PG8_SCHED __builtin_amdgcn_sched_barrier(0)
    Unit cur, nxt; int ui = 0;
    if (!S.next(0, cur)) return;
    f32x4 acc[2][2][4][2];
#pragma unroll
    for (int a = 0; a < 2; ++a)
#pragma unroll
        for (int b = 0; b < 2; ++b)
#pragma unroll
            for (int m = 0; m < 4; ++m)
#pragma unroll
                for (int n = 0; n < 2; ++n) acc[a][b][m][n] = (f32x4){0.f, 0.f, 0.f, 0.f};
    bf16x8 At[4][2], B0[2][2], B1[2][2];
    const char* cA = (const char*)g.A + (size_t)cur.pm * tstep; const char* cB = (const char*)g.Bt + (size_t)cur.pn * tstep;
    S.a_ready(cur);
    if constexpr (SP2) {
        PG8_STAGE(PG8_SB(0, 0), cB, voffB); PG8_STAGE(PG8_SB(0, 1), cB + hstep, voffB); PG8_STAGE(PG8_SA(0, 0), cA, voffA); PG8_STAGE(PG8_SA(0, 1), cA + hstep, voffA);
        if (wr == 1) PG8_BAR;
        PG8_WAIT_V(2); PG8_BAR;
        PG8_STAGE(PG8_SB(1, 0), cB + kstep, voffB); PG8_STAGE(PG8_SA(1, 0), cA + kstep, voffA); PG8_STAGE(PG8_SB(1, 1), cB + hstep + kstep, voffB);
        PG8_WAIT_V(6); PG8_BAR;
    } else {
        PG8_STAGE(PG8_SB(0, 0), cB, voffB); PG8_STAGE(PG8_SA(0, 0), cA, voffA); PG8_STAGE(PG8_SB(0, 1), cB + hstep, voffB); PG8_STAGE(PG8_SA(0, 1), cA + hstep, voffA);
        if (wr == 1) PG8_BAR;
        PG8_WAIT_V(4); PG8_BAR;
        PG8_STAGE(PG8_SB(1, 0), cB + kstep, voffB); PG8_STAGE(PG8_SA(1, 0), cA + kstep, voffA); PG8_STAGE(PG8_SB(1, 1), cB + hstep + kstep, voffB);
        PG8_WAIT_V(6); PG8_BAR;
    }
    for (;;) {
        const bool has_next = S.next(ui + 1, nxt);
        const char* nA = has_next ? (const char*)g.A + (size_t)nxt.pm * tstep : cA; const char* nB = has_next ? (const char*)g.Bt + (size_t)nxt.pn * tstep : cB;
        for (int t = 0; t < nt; t += 2) {
            const bool last = (t == nt - 2);
            const char* a1 = cA + (size_t)(t + 1) * kstep;
            const char* a2 = last ? nA : cA + (size_t)(t + 2) * kstep; const char* b2 = last ? nB : cB + (size_t)(t + 2) * kstep;
            const char* a3 = a2 + kstep; const char* b3 = b2 + kstep;
            if (last && has_next) S.a_ready(nxt);
            if constexpr (SP2) {
            PG8_LDB(B0, 0, 0); PG8_LDB(B1, 0, 1); PG8_SCHED; PG8_LDA(At, 0, 0); PG8_STAGE(PG8_SA(1, 1), a1 + hstep, voffA);
            PG8_WAIT_V(8); PG8_WAIT_L(0); PG8_BAR; PG8_MMA(0, 0, At, B0); PG8_MMA(0, 1, At, B1); PG8_BAR; PG8_SCHED;
            PG8_LDA(At, 0, 1); PG8_STAGE(PG8_SB(0, 0), b2, voffB); PG8_STAGE(PG8_SB(0, 1), b2 + hstep, voffB); PG8_STAGE(PG8_SA(0, 0), a2, voffA);
            PG8_WAIT_V(8); PG8_WAIT_L(0); PG8_BAR; PG8_MMA(1, 0, At, B0); PG8_MMA(1, 1, At, B1); PG8_BAR; PG8_SCHED;
            PG8_LDB(B0, 1, 0); PG8_LDB(B1, 1, 1); PG8_SCHED; PG8_LDA(At, 1, 0); PG8_STAGE(PG8_SA(0, 1), a2 + hstep, voffA);
            PG8_WAIT_V(8); PG8_WAIT_L(0); PG8_BAR; PG8_MMA(0, 0, At, B0); PG8_MMA(0, 1, At, B1); PG8_BAR; PG8_SCHED;
            PG8_LDA(At, 1, 1); PG8_STAGE(PG8_SB(1, 0), b3, voffB); PG8_STAGE(PG8_SB(1, 1), b3 + hstep, voffB); PG8_STAGE(PG8_SA(1, 0), a3, voffA);
            PG8_WAIT_V(8); PG8_WAIT_L(0); PG8_BAR; PG8_MMA(1, 0, At, B0); PG8_MMA(1, 1, At, B1); PG8_BAR; PG8_SCHED;
            } else {
            PG8_LDB(B0, 0, 0); PG8_SCHED; PG8_LDA(At, 0, 0); PG8_STAGE(PG8_SA(1, 1), a1 + hstep, voffA);
            PG8_WAIT_L(8); PG8_BAR; PG8_WAIT_L(0); PG8_MMA(0, 0, At, B0); PG8_BAR; PG8_SCHED;
            PG8_LDB(B1, 0, 1); PG8_STAGE(PG8_SB(0, 0), b2, voffB);
            PG8_BAR; PG8_WAIT_L(0); PG8_MMA(0, 1, At, B1); PG8_BAR;
            PG8_LDA(At, 0, 1); PG8_STAGE(PG8_SA(0, 0), a2, voffA);
            PG8_BAR; PG8_WAIT_L(0); PG8_MMA(1, 0, At, B0); PG8_BAR; PG8_SCHED;
            PG8_STAGE(PG8_SB(0, 1), b2 + hstep, voffB);
            PG8_WAIT_V(6); PG8_BAR; PG8_MMA(1, 1, At, B1); PG8_BAR;
            PG8_LDB(B0, 1, 0); PG8_SCHED; PG8_LDA(At, 1, 0); PG8_STAGE(PG8_SA(0, 1), a2 + hstep, voffA);
            PG8_WAIT_L(8); PG8_BAR; PG8_WAIT_L(0); PG8_MMA(0, 0, At, B0); PG8_BAR; PG8_SCHED;
            PG8_LDB(B1, 1, 1); PG8_STAGE(PG8_SB(1, 0), b3, voffB);
            PG8_BAR; PG8_WAIT_L(0); PG8_MMA(0, 1, At, B1); PG8_BAR;
            PG8_LDA(At, 1, 1); PG8_STAGE(PG8_SA(1, 0), a3, voffA);
            PG8_BAR; PG8_WAIT_L(0); PG8_MMA(1, 0, At, B0); PG8_BAR; PG8_SCHED;
            PG8_STAGE(PG8_SB(1, 1), b3 + hstep, voffB);
            PG8_WAIT_V(6); PG8_BAR; PG8_MMA(1, 1, At, B1); PG8_BAR;
            }
        }
        if constexpr (ALIGN_EPI) { if (wr == 0) PG8_BAR; }
        if constexpr (!Epi::AFTER_DRAIN) { E(acc, cur, wr, wc, fr, fq); S.done(cur); }
        if (!has_next) break;
#pragma unroll
        for (int a = 0; a < 2; ++a)
#pragma unroll
            for (int b = 0; b < 2; ++b)
#pragma unroll
                for (int m = 0; m < 4; ++m)
#pragma unroll
                    for (int n = 0; n < 2; ++n) acc[a][b][m][n] = (f32x4){0.f, 0.f, 0.f, 0.f};
        cur = nxt; cA = nA; cB = nB; ++ui;
        if constexpr (ALIGN_EPI) { if (wr == 1) PG8_BAR; }
    }
    PG8_WAIT_V(0);
    if constexpr (!ALIGN_EPI) { if (wr == 0) PG8_BAR; }
    PG8_BAR;
    if constexpr (Epi::AFTER_DRAIN) { E.fused(acc, cur, wr, wc, fr, fq, lds, wid, lane); S.done(cur); }
#undef PG8_SA
#undef PG8_SB
#undef PG8_STAGE
#undef PG8_LDA
#undef PG8_LDB
#undef PG8_MMA
#undef PG8_WAIT_V
#undef PG8_WAIT_L
#undef PG8_BAR
#undef PG8_SCHED
}
}

#ifndef PG8_SP2
#define PG8_SP2 true
#endif
#ifndef PG8_ALIGN
#define PG8_ALIGN true
#endif
#ifndef MK_N_LAUNCHES
#define MK_N_LAUNCHES 1
#endif
constexpr int NWAVES = 8;
constexpr int BATCH = 2, SEQ = 8192, D = 1024, M = BATCH * SEQ;
constexpr int HD = 64;
constexpr int AB_PROJ = 2304, C_PROJ = 1536;
constexpr int NEXP = 32, DFF = 256;
constexpr int SLOT_CAP = 40960;
constexpr float RMS_EPS = 1e-6f;
constexpr float LOG2E = 1.4426950408889634f;
constexpr float C2 = 0.125f * LOG2E;
constexpr int NPHASE = 19;

constexpr size_t MiB = 1u << 20;
constexpr size_t WS_CTL = 0, CTL_ZERO_BYTES = 1 * MiB;
constexpr size_t WS_CONST = 1 * MiB;
constexpr size_t WS_WABIN = 2 * MiB, WS_WABOUT = 7 * MiB, WS_WCIN = 9 * MiB, WS_WCOUT = 12 * MiB;
constexpr size_t WS_WGU = 14 * MiB;
constexpr size_t WS_WD = 78 * MiB;
constexpr size_t WS_XN = 110 * MiB;
constexpr size_t WS_ROUTE = 142 * MiB;
constexpr size_t WS_P = 144 * MiB;
constexpr size_t WS_QAB = WS_P, WS_KA = WS_P + 32 * MiB, WS_VA = WS_P + 48 * MiB, WS_KVB = WS_P + 64 * MiB;
constexpr size_t WS_Q1 = WS_P, WS_K1 = WS_P + 32 * MiB, WS_V1 = WS_P + 40 * MiB;
constexpr size_t WS_XG = WS_P, WS_A2 = WS_P + 80 * MiB;
constexpr size_t WS_END = WS_P + 100 * MiB;
static_assert((size_t)SLOT_CAP * 1024 * 2 == 80 * MiB && (size_t)SLOT_CAP * 256 * 2 == 20 * MiB, "slot buffers");
constexpr int CW_TMO = 0;
constexpr int CW_BAR = 4096;
constexpr int CW_CNT = 16384;

constexpr int RING_OFF = 0, RING_BYTES = 131072;
constexpr int LDSCTL_OFF = RING_BYTES, MISC_OFF = LDSCTL_OFF + 320;
constexpr int LDS_BYTES = 147456;
#define GAS __attribute__((address_space(1)))
#define LAS __attribute__((address_space(3)))
typedef unsigned short bf16;
typedef unsigned v4u __attribute__((ext_vector_type(4)));
typedef float f32x4 __attribute__((ext_vector_type(4)));
typedef short bf16x8 __attribute__((ext_vector_type(8)));
typedef GAS unsigned gu32;
typedef GAS unsigned long long gu64;
#define RLX_AGENT __ATOMIC_RELAXED, __HIP_MEMORY_SCOPE_AGENT
#define LDS_WAIT() asm volatile("s_waitcnt lgkmcnt(0)" ::: "memory")
#define VM_WAIT() asm volatile("s_waitcnt vmcnt(0)" ::: "memory")
__device__ __forceinline__ unsigned long long rt() { return __builtin_amdgcn_s_memrealtime(); }
__device__ __forceinline__ unsigned f2bf(float f) { unsigned u = __builtin_bit_cast(unsigned, f); return (u + 0x7fffu + ((u >> 16) & 1u)) >> 16; }
__device__ __forceinline__ unsigned pk2(float lo, float hi) { return f2bf(lo) | (f2bf(hi) << 16); }
#define XB_TMO      128
#define XB_XCNT(j)  (256  + 64 * (j))
#define XB_XSUB(j)  (1280 + 64 * (j))
#define XB_XGEN(j)  (2304 + 64 * (j))
#define XB_TOP      3328
#define XB_TOPGEN   3392
#define XCD_BAR_WORDS 3456
#define XB_SPIN_CAP (1u << 18)

__device__ __forceinline__ unsigned xb_ld(unsigned* p)              { return __hip_atomic_load(p, __ATOMIC_RELAXED, __HIP_MEMORY_SCOPE_AGENT); }
__device__ __forceinline__ unsigned xb_add(unsigned* p, unsigned v) { return __hip_atomic_fetch_add(p, v, __ATOMIC_RELAXED, __HIP_MEMORY_SCOPE_AGENT); }
__device__ __forceinline__ unsigned xb_xcc_id() { return (unsigned)__builtin_amdgcn_s_getreg((3 << 11) | 20) & 0xFu; }
#define XB_SPIN(cond, bar) do { unsigned _sp = 0; while (cond) { __builtin_amdgcn_s_sleep(1); \
    if ((++_sp & 255u) == 0u) { if (xb_ld(&(bar)[XB_TMO])) break; if (_sp > XB_SPIN_CAP) { atomicAdd(&(bar)[XB_TMO], 1u); break; } } } } while (0)

struct XcdBarrier {
    unsigned* bar; unsigned x; int tid;
    volatile LAS unsigned* st;
};

__device__ __forceinline__ XcdBarrier xcd_barrier_post(unsigned* bar, volatile LAS unsigned* st) {
    XcdBarrier b; b.bar = bar; b.x = xb_xcc_id(); b.st = st;
    if (threadIdx.x == 0) (void)xb_add(&bar[XB_XCNT(b.x)], 1u);
    return b;
}
__device__ __forceinline__ void xcd_barrier_complete(unsigned* bar, unsigned x, unsigned& nloc, unsigned& nx) {
    const unsigned G = gridDim.x * gridDim.y * gridDim.z;
    unsigned sum, cnt, mine, sp = 0u;
    for (;;) {
        sum = 0u; cnt = 0u; mine = 0u;
#pragma unroll
        for (unsigned j = 0; j < 16; ++j) { const unsigned c = xb_ld(&bar[XB_XCNT(j)]); sum += c; cnt += (c > 0u) ? 1u : 0u; mine = (j == x) ? c : mine; }
        if (sum == G) break;
        __builtin_amdgcn_s_sleep(1);
        if ((++sp & 255u) == 0u) { if (xb_ld(&bar[XB_TMO])) break; if (sp > XB_SPIN_CAP) { atomicAdd(&bar[XB_TMO], 1u); break; } }
    }
    nloc = mine > 0u ? mine : 1u; nx = cnt > 0u ? cnt : 1u;
}

__device__ __forceinline__ void xcd_barrier(const XcdBarrier& b) {
    asm volatile("s_waitcnt vmcnt(0)" ::: "memory");
    __syncthreads();
    if (b.tid == 0) {
        unsigned* bar = b.bar;
        __builtin_amdgcn_s_waitcnt(0);
        unsigned nloc = b.st[0], nx = b.st[1];
        if (nloc == 0u) { xcd_barrier_complete(bar, b.x, nloc, nx); b.st[0] = nloc; b.st[1] = nx; }
        const unsigned old = xb_add(&bar[XB_XSUB(b.x)], 1u);
        const unsigned gen = old / nloc;
        if (old + 1u == (gen + 1u) * nloc) {
            __builtin_amdgcn_fence(__ATOMIC_RELEASE, "agent");
            asm volatile("s_waitcnt vmcnt(0)" ::: "memory");
            const unsigned og = xb_add(&bar[XB_TOP], 1u);
            const unsigned tg = og / nx;
            if (og + 1u == (tg + 1u) * nx) xb_add(&bar[XB_TOPGEN], 1u);
            else XB_SPIN(xb_ld(&bar[XB_TOPGEN]) == tg, bar);
            __builtin_amdgcn_fence(__ATOMIC_ACQUIRE, "agent");
            xb_add(&bar[XB_XGEN(b.x)], 1u);
            asm volatile("s_waitcnt vmcnt(0)" ::: "memory");
        } else {
            XB_SPIN(xb_ld(&bar[XB_XGEN(b.x)]) == gen, bar);
            __builtin_amdgcn_fence(__ATOMIC_ACQUIRE, "agent");
            asm volatile("s_waitcnt vmcnt(0)" ::: "memory");
        }
    }
    __syncthreads();
}

namespace pg8 { typedef ResL0T<(unsigned)WS_QAB, (unsigned)WS_KA, (unsigned)WS_VA, (unsigned)WS_KVB> ResL0; typedef ResL1T<(unsigned)WS_Q1, (unsigned)WS_K1, (unsigned)WS_V1> ResL1; }
#define DI __device__ __forceinline__
struct Args { const float* in[21]; float* out; unsigned char* ws; int ph_lo, ph_hi; };
typedef const __attribute__((address_space(4))) Args* KArgs;
struct Frame {
    LAS unsigned char* lds;
    volatile LAS unsigned* MISC;
    gu32* ctl;
    int tid, lane, wave, vcu, G;
    unsigned char* ws;
    KArgs a;
    float* out;
};
enum { I_X = 0, I_MIXN, I_FFNN, I_ABWIN, I_AQN, I_AKN, I_BQN, I_BKN, I_BSINK, I_ABWOUT, I_CWIN, I_CQN, I_CKN, I_CWOUT, I_MGW, I_MGB, I_MEW, I_MEB, I_WGATE, I_WUP, I_WDOWN };

template <int PAT> DI float swz_f(float v) { return __builtin_bit_cast(float, __builtin_amdgcn_ds_swizzle(__builtin_bit_cast(int, v), PAT)); }
template <int CTRL> DI float dpp_f(float v) { return __builtin_bit_cast(float, __builtin_amdgcn_update_dpp(0, __builtin_bit_cast(int, v), CTRL, 0xf, 0xf, true)); }
DI float xor1_f(float v) { return dpp_f<0xB1>(v); }
DI float xor2_f(float v) { return dpp_f<0x4E>(v); }
DI float wave_sum(float v) {
    v += xor1_f(v); v += xor2_f(v);
    v += swz_f<(4 << 10) | 0x1f>(v); v += swz_f<(8 << 10) | 0x1f>(v); v += swz_f<(16 << 10) | 0x1f>(v);
    float a_ = v, b_ = v;
    asm volatile("s_nop 1\n\tv_permlane32_swap_b32 %0, %1\n\ts_nop 1" : "+v"(a_), "+v"(b_));
    return a_ + b_;
}
DI float bf2f(unsigned short b) { return __builtin_bit_cast(float, (unsigned)b << 16); }

DI void tr_item(const float* W, int N, bf16* WT, int dstK, int drow, LAS float* scr, int k0, int n0, int lane) {
#pragma unroll 8
    for (int i = 0; i < 32; ++i) { const int kk = 2 * i + (lane >> 5); scr[kk * 33 + (lane & 31)] = W[(size_t)(k0 + kk) * N + n0 + (lane & 31)]; }
    LDS_WAIT(); asm volatile("" ::: "memory");
    const int c = lane & 7;
#pragma unroll
    for (int j = 0; j < 4; ++j) { const int n = (lane >> 3) + 8 * j; const LAS float* s = scr + (8 * c) * 33 + n;
        v4u o; o.x = pk2(s[0 * 33], s[1 * 33]); o.y = pk2(s[2 * 33], s[3 * 33]); o.z = pk2(s[4 * 33], s[5 * 33]); o.w = pk2(s[6 * 33], s[7 * 33]);
        *(GAS v4u*)(WT + (size_t)(drow + n) * dstK + k0 + 8 * c) = o; }
    LDS_WAIT(); asm volatile("" ::: "memory");
}
DI void load_row16(const float* row, int lane, f32x4 (&v)[4]) {
    const GAS f32x4* xr = (const GAS f32x4*)row + lane;
#pragma unroll
    for (int j = 0; j < 4; ++j) v[j] = xr[64 * j];
}
DI float row_rinv(const f32x4 (&v)[4]) {
    float s = 0.f;
#pragma unroll
    for (int j = 0; j < 4; ++j) s += (v[j].x * v[j].x + v[j].y * v[j].y) + (v[j].z * v[j].z + v[j].w * v[j].w);
    return 1.0f / sqrtf(wave_sum(s) * (1.f / D) + RMS_EPS);
}
DI void row_norm_store(f32x4 (&v)[4], float rinv, const float* g, bf16* orow, int lane) {
    const GAS f32x4* gr = (const GAS f32x4*)g + lane;
    GAS unsigned long long* o8 = (GAS unsigned long long*)orow + lane;
#pragma unroll
    for (int j = 0; j < 4; ++j) { const f32x4 gg = gr[64 * j]; v[j] = v[j] * rinv * gg;
        o8[64 * j] = (unsigned long long)pk2(v[j].x, v[j].y) | ((unsigned long long)pk2(v[j].z, v[j].w) << 32); }
}
DI void p_prologue(Frame& F) {
    LAS float* scr = (LAS float*)(F.lds + RING_OFF + F.wave * 16384);
    const int gw = F.vcu * NWAVES + F.wave, NGW = F.G * NWAVES;
    constexpr int I0 = 16 * 72, I1 = 16 * 32, I2 = 16 * 48, I3 = 16 * 32, IE = 64 * 128;
    constexpr int NITEMS = I0 + I1 + I2 + I3 + 3 * IE;
    for (int it = gw; it < NITEMS; it += NGW) {
        int r = it;
        if (r < I0) { tr_item(F.a->in[I_ABWIN], AB_PROJ, (bf16*)(F.ws + WS_WABIN), 1024, 32 * (r % 72), scr, 64 * (r / 72), 32 * (r % 72), F.lane); continue; } r -= I0;
        if (r < I1) { tr_item(F.a->in[I_ABWOUT], 1024, (bf16*)(F.ws + WS_WABOUT), 1024, 32 * (r % 32), scr, 64 * (r / 32), 32 * (r % 32), F.lane); continue; } r -= I1;
        if (r < I2) { tr_item(F.a->in[I_CWIN], C_PROJ, (bf16*)(F.ws + WS_WCIN), 1024, 32 * (r % 48), scr, 64 * (r / 48), 32 * (r % 48), F.lane); continue; } r -= I2;
        if (r < I3) { tr_item(F.a->in[I_CWOUT], 1024, (bf16*)(F.ws + WS_WCOUT), 1024, 32 * (r % 32), scr, 64 * (r / 32), 32 * (r % 32), F.lane); continue; } r -= I3;
        if (r < 2 * IE) {
            const int up = r >= IE ? 1 : 0; r -= up * IE;
            const int mat = r >> 7, itx = r & 127, kb = itx >> 3, nb = itx & 7, l = mat >> 5, E = mat & 31, n0 = 32 * nb;
            const float* src = F.a->in[up ? I_WUP : I_WGATE] + (size_t)mat * 262144;
            bf16* dst = (bf16*)(F.ws + WS_WGU) + (size_t)l * (32 * 512 * 1024);
            tr_item(src, 256, dst, 1024, E * 512 + (n0 >> 7) * 256 + (n0 & 127) + up * 128, scr, 64 * kb, n0, F.lane); continue; }
        r -= 2 * IE;
        {
            const int mat = r >> 7, itx = r & 127, kb = itx >> 5, nb = itx & 31, l = mat >> 5, E = mat & 31, n0 = 32 * nb;
            const float* src = F.a->in[I_WDOWN] + (size_t)mat * 262144;
            bf16* dst = (bf16*)(F.ws + WS_WD) + (size_t)l * (32 * 1024 * 256);
            tr_item(src, 1024, dst, 256, E * 1024 + n0, scr, 64 * kb, n0, F.lane); }
    }
    float* cst = (float*)(F.ws + WS_CONST);
    {
        const int gt = (F.vcu * NWAVES + F.wave) * 64 + F.lane;
        if (gt < 3072) {
            const int isc = gt >= 2048 ? 1 : 0, e = isc ? gt - 2048 : gt, pos = e >> 4, i = e & 15;
            const float invf = exp2f(-(float)(2 * i) * (1.0f / 32.0f) * 13.287712379549449f);
            const float ang = (float)pos * invf;
            float* t = cst + 1024 + (isc ? 4096 : 0) + (size_t)pos * 32 + i;
            t[0] = cosf(ang); t[16] = sinf(ang);
        }
        if (gt == 4096) {
            float aq = 0.f, ak = 0.f, bq = 0.f, bk = 0.f, cq = 0.f, ck = 0.f;
            for (int i = 0; i < 64; ++i) { aq = fmaxf(aq, fabsf(F.a->in[I_AQN][i])); ak = fmaxf(ak, fabsf(F.a->in[I_AKN][i])); bq = fmaxf(bq, fabsf(F.a->in[I_BQN][i]));
                bk = fmaxf(bk, fabsf(F.a->in[I_BKN][i])); cq = fmaxf(cq, fabsf(F.a->in[I_CQN][i])); ck = fmaxf(ck, fabsf(F.a->in[I_CKN][i])); }
            cst[0] = 8.0f * aq * ak * LOG2E * 1.02f;
            const float mb = 8.0f * bq * bk * LOG2E * 1.02f;
            for (int h = 0; h < 8; ++h) cst[1 + h] = fmaxf(mb, F.a->in[I_BSINK][h] * LOG2E);
            cst[9] = 8.0f * cq * ck * LOG2E * 1.02f;
        }
    }
    for (int m = gw; m < M; m += NGW) { f32x4 v[4]; load_row16(F.a->in[I_X] + (size_t)m * D, F.lane, v); const float rinv = row_rinv(v);
        row_norm_store(v, rinv, F.a->in[I_MIXN], (bf16*)(F.ws + WS_XN) + (size_t)m * D, F.lane); }
}

DI void headnorm16(bf16* p, const float* gain, int sub, float scale, bool active, int pos, const float* rtab) {
    v4u raw0 = *(const GAS v4u*)p, raw1 = *((const GAS v4u*)p + 1);
    float y[16];
    y[0] = bf2f(raw0.x & 0xffff); y[1] = bf2f(raw0.x >> 16); y[2] = bf2f(raw0.y & 0xffff); y[3] = bf2f(raw0.y >> 16);
    y[4] = bf2f(raw0.z & 0xffff); y[5] = bf2f(raw0.z >> 16); y[6] = bf2f(raw0.w & 0xffff); y[7] = bf2f(raw0.w >> 16);
    y[8] = bf2f(raw1.x & 0xffff); y[9] = bf2f(raw1.x >> 16); y[10] = bf2f(raw1.y & 0xffff); y[11] = bf2f(raw1.y >> 16);
    y[12] = bf2f(raw1.z & 0xffff); y[13] = bf2f(raw1.z >> 16); y[14] = bf2f(raw1.w & 0xffff); y[15] = bf2f(raw1.w >> 16);
    float ss = 0.f;
#pragma unroll
    for (int i = 0; i < 16; ++i) ss += y[i] * y[i];
    ss += xor1_f(ss); ss += xor2_f(ss);
    const float rinv = 1.0f / sqrtf(ss * (1.0f / 64.0f) + RMS_EPS);
    const float* gp = gain + 16 * sub;
#pragma unroll
    for (int i = 0; i < 16; ++i) y[i] = y[i] * rinv * gp[i];
    if (pos >= 0) {
        const int tp = (sub < 2) ? (pos >> 6) : 128 + (pos & 63);
        const float* t = rtab + (size_t)tp * 32;
#pragma unroll
        for (int i = 0; i < 16; ++i) { const float yp = xor1_f(y[i]); const float c = t[i], s = t[16 + i];
            y[i] = (sub & 1) ? (y[i] * c + yp * s) : (y[i] * c - yp * s); }
    }
    if (active) {
        v4u o0, o1;
        o0.x = pk2(y[0] * scale, y[1] * scale); o0.y = pk2(y[2] * scale, y[3] * scale); o0.z = pk2(y[4] * scale, y[5] * scale); o0.w = pk2(y[6] * scale, y[7] * scale);
        o1.x = pk2(y[8] * scale, y[9] * scale); o1.y = pk2(y[10] * scale, y[11] * scale); o1.z = pk2(y[12] * scale, y[13] * scale); o1.w = pk2(y[14] * scale, y[15] * scale);
        *(GAS v4u*)p = o0; *((GAS v4u*)p + 1) = o1;
    }
}
DI void p_headnorm(Frame& F, int layer) {
    const int gw = F.vcu * NWAVES + F.wave, NGW = F.G * NWAVES, lane = F.lane, hc = lane >> 2, sub = lane & 3;
    const float* rtab = (const float*)(F.ws + WS_CONST) + 1024;
    if (layer == 0) {
        const int NCH = M + M / 2 + M / 4;
        for (int c = gw; c < NCH; c += NGW) {
            if (c < M) { bf16* p = (bf16*)(F.ws + WS_QAB) + (size_t)c * 1024 + lane * 16; headnorm16(p, hc < 8 ? F.a->in[I_AQN] : F.a->in[I_BQN], sub, C2, true, -1, rtab); }
            else if (c < M + M / 2) { bf16* p = (bf16*)(F.ws + WS_KA) + (size_t)(c - M) * 1024 + lane * 16; headnorm16(p, F.a->in[I_AKN], sub, 1.0f, true, -1, rtab); }
            else { bf16* p = (bf16*)(F.ws + WS_KVB) + (size_t)(c - M - M / 2) * 1024 + lane * 16; headnorm16(p, F.a->in[I_BKN], sub, 1.0f, (hc & 3) < 2, -1, rtab); }
        }
    } else {
        const int NCH = M + M / 4;
        for (int c = gw; c < NCH; c += NGW) {
            if (c < M) { bf16* p = (bf16*)(F.ws + WS_Q1) + (size_t)c * 1024 + lane * 16; headnorm16(p, F.a->in[I_CQN], sub, C2, true, c & (SEQ - 1), rtab); }
            else { const int cc = c - M; bf16* p = (bf16*)(F.ws + WS_K1) + (size_t)cc * 1024 + lane * 16; headnorm16(p, F.a->in[I_CKN], sub, 1.0f, true, (cc * 4 + (hc >> 2)) & (SEQ - 1), rtab); }
        }
    }
}

namespace att {
using bf16x8 = __attribute__((ext_vector_type(8))) short;
using s16x4 = __attribute__((ext_vector_type(4))) short;
using f32x16 = __attribute__((ext_vector_type(16))) float;
using u32x4 = __attribute__((ext_vector_type(4))) unsigned;
typedef __attribute__((address_space(3))) const char* lds_cptr;
typedef short v4i16_t __attribute__((ext_vector_type(4)));
typedef float f32x2_t __attribute__((ext_vector_type(2))); typedef __bf16 bf16x2_t __attribute__((ext_vector_type(2)));
DI int crow(int r, int hi) { return (r & 3) + 8 * (r >> 2) + 4 * hi; }
DI s16x4 vtr(lds_cptr p) { return __builtin_bit_cast(s16x4, __builtin_amdgcn_ds_read_tr16_b64_v4i16((__attribute__((address_space(3))) v4i16_t*)p)); }
DI unsigned cvtpk(float lo, float hi) { f32x2_t v = {lo, hi}; bf16x2_t b = __builtin_convertvector(v, bf16x2_t); return __builtin_bit_cast(unsigned, b); }
#define MFMA32(a, b, c) __builtin_amdgcn_mfma_f32_32x32x16_bf16((a), (b), (c), 0, 0, 0)

template <bool MASK>
DI void run_seg(f32x16 (&o)[2], f32x16& lsum, const bf16x8 (&qf)[4], const unsigned short* Kb, const unsigned short* Vb, int kvpitch,
                int ktok0, int kstride, int nsub, int window, float slope2, float negM, int tq, LAS unsigned char* vst, int lane) {
    const int r32 = lane & 31, hi = lane >> 5;
    const lds_cptr vrd = (lds_cptr)vst + ((lane >> 4) & 1) * 32 + (lane & 3) * 8 + (4 * hi + ((lane & 15) >> 2)) * 64;
    const short one = (short)0x3F80; const bf16x8 ones = {one, one, one, one, one, one, one, one};
    for (int s = 0; s < nsub; ++s) {
        const int j0 = 32 * s;
        int tk = ktok0 + kstride * (j0 + r32); tk = tk < 0 ? 0 : (tk > SEQ - 1 ? SEQ - 1 : tk);
        const unsigned short* kp = Kb + (size_t)tk * kvpitch + 8 * hi;
        bf16x8 kf[4];
#pragma unroll
        for (int d0 = 0; d0 < 4; ++d0) kf[d0] = *(const bf16x8*)(kp + 16 * d0);
        u32x4 vv[4];
#pragma unroll
        for (int pc = 0; pc < 4; ++pc) { int tv = ktok0 + kstride * (j0 + 16 * (pc & 1) + (lane >> 2)); tv = tv < 0 ? 0 : (tv > SEQ - 1 ? SEQ - 1 : tv);
            vv[pc] = *(const u32x4*)(Vb + (size_t)tv * kvpitch + (pc >> 1) * 32 + (lane & 3) * 8); }
        asm volatile("" ::: "memory");
#pragma unroll
        for (int pc = 0; pc < 4; ++pc) *(LAS u32x4*)(vst + pc * 1024 + lane * 16) = vv[pc];
        f32x16 p;
#pragma unroll
        for (int r = 0; r < 16; ++r) p[r] = negM;
#pragma unroll
        for (int d0 = 0; d0 < 4; ++d0) p = MFMA32(kf[d0], qf[d0], p);
        if (MASK) {
#pragma unroll
            for (int r = 0; r < 16; ++r) { const int tkr = ktok0 + kstride * (j0 + crow(r, hi)); const int dt = tkr - tq; const int ad = dt < 0 ? -dt : dt;
                const bool ok = (ad <= window) && (tkr >= 0) && (tkr < SEQ); p[r] = ok ? p[r] - slope2 * (float)ad : -INFINITY; }
        }
#pragma unroll
        for (int r = 0; r < 16; ++r) p[r] = __builtin_amdgcn_exp2f(p[r]);
        u32x4 w0, w1;
        w0.x = cvtpk(p[0], p[1]); w0.y = cvtpk(p[2], p[3]); w0.z = cvtpk(p[4], p[5]); w0.w = cvtpk(p[6], p[7]);
        w1.x = cvtpk(p[8], p[9]); w1.y = cvtpk(p[10], p[11]); w1.z = cvtpk(p[12], p[13]); w1.w = cvtpk(p[14], p[15]);
        const bf16x8 pa0 = __builtin_bit_cast(bf16x8, w0), pa1 = __builtin_bit_cast(bf16x8, w1);
        asm volatile("" ::: "memory");
#pragma unroll
        for (int s2 = 0; s2 < 2; ++s2)
#pragma unroll
            for (int d0 = 0; d0 < 2; ++d0) { const s16x4 lo4 = vtr(vrd + d0 * 2048 + s2 * 1024), hi4 = vtr(vrd + d0 * 2048 + s2 * 1024 + 512);
                const bf16x8 vb = {lo4[0], lo4[1], lo4[2], lo4[3], hi4[0], hi4[1], hi4[2], hi4[3]};
                o[d0] = MFMA32(s2 ? pa1 : pa0, vb, o[d0]); }
        lsum = MFMA32(pa0, ones, lsum); lsum = MFMA32(pa1, ones, lsum);
        asm volatile("" ::: "memory");
    }
}
DI void load_q(bf16x8 (&qf)[4], const unsigned short* Q, int qpitch, int tq, int hi) {
    const unsigned short* qp = Q + (size_t)tq * qpitch + 8 * hi;
#pragma unroll
    for (int d0 = 0; d0 < 4; ++d0) qf[d0] = *(const bf16x8*)(qp + 16 * d0);
}
DI void store_o(const f32x16 (&o)[2], const f32x16& lsum, float lextra, unsigned short* O, int opitch, int qtok0, int qstride, int lane) {
    const int r32 = lane & 31, hi = lane >> 5;
#pragma unroll
    for (int r = 0; r < 16; ++r) { const float inv = 1.0f / (lsum[r] + lextra); unsigned short* op = O + (size_t)(qtok0 + qstride * crow(r, hi)) * opitch + r32;
        op[0] = (unsigned short)f2bf(o[0][r] * inv); op[32] = (unsigned short)f2bf(o[1][r] * inv); }
}
}

DI void p_attn_l0(Frame& F) {
    using namespace att;
    const int gw = F.vcu * NWAVES + F.wave, NGW = F.G * NWAVES, lane = F.lane, r32 = lane & 31, hi = lane >> 5;
    LAS unsigned char* vst = F.lds + RING_OFF + F.wave * 4096;
    const float* cst = (const float*)(F.ws + WS_CONST);
    unsigned short* QAB = (unsigned short*)(F.ws + WS_QAB); const unsigned short* KA = (const unsigned short*)(F.ws + WS_KA); const unsigned short* VA = (const unsigned short*)(F.ws + WS_VA);
    const unsigned short* KVB = (const unsigned short*)(F.ws + WS_KVB);
    for (int id = gw; id < 8192; id += NGW) {
        f32x16 o[2], lsum;
#pragma unroll
        for (int r = 0; r < 16; ++r) { o[0][r] = 0.f; o[1][r] = 0.f; lsum[r] = 0.f; }
        bf16x8 qf[4];
        if (id < 4096) {
            const int res = id & 15, span = (id >> 4) & 15, h = (id >> 8) & 7, b = id >> 11;
            const int t0 = span * 512 + res; const size_t rb = (size_t)b * SEQ;
            unsigned short* Qh = QAB + rb * 1024 + h * 64; const unsigned short* Kh = KA + rb * 512 + h * 64; const unsigned short* Vh = VA + rb * 512 + h * 64;
            const int tq = t0 + 16 * r32;
            load_q(qf, Qh, 1024, tq, hi);
            const float slope2 = exp2f(-0.5f * (float)(2 * h + 1)) * LOG2E, negM = -cst[0];
            run_seg<true>(o, lsum, qf, Kh, Vh, 512, t0 - 1024, 16, 5, 1024, slope2, negM, tq, vst, lane);
            run_seg<true>(o, lsum, qf, Kh, Vh, 512, t0 - 256, 4, 8, 256, slope2, negM, tq, vst, lane);
            run_seg<true>(o, lsum, qf, Kh, Vh, 512, t0 - 64, 1, 20, 64, slope2, negM, tq, vst, lane);
            store_o(o, lsum, 0.f, Qh, 1024, t0, 16, lane);
        } else {
            const int id2 = id - 4096, blk = id2 & 255, h = (id2 >> 8) & 7, b = id2 >> 11;
            const int t0 = blk * 32; const size_t rb = (size_t)b * SEQ;
            unsigned short* Qh = QAB + rb * 1024 + 512 + h * 64; const unsigned short* Kh = KVB + rb * 256 + (h >> 2) * 64; const unsigned short* Vh = KVB + rb * 256 + 128 + (h >> 2) * 64;
            const int tq = t0 + r32;
            load_q(qf, Qh, 1024, tq, hi);
            const float Mh = cst[1 + h];
            const float slope2 = exp2f(-(float)(h + 1)) * LOG2E;
            run_seg<true>(o, lsum, qf, Kh, Vh, 256, t0 - 128, 1, 9, 128, slope2, -Mh, tq, vst, lane);
            const float lextra = exp2f(F.a->in[I_BSINK][h] * LOG2E - Mh);
            store_o(o, lsum, lextra, Qh, 1024, t0, 1, lane);
        }
    }
}
DI void p_attn_l1(Frame& F) {
    using namespace att;
    const int gw = F.vcu * NWAVES + F.wave, NGW = F.G * NWAVES, lane = F.lane, r32 = lane & 31, hi = lane >> 5;
    LAS unsigned char* vst = F.lds + RING_OFF + F.wave * 4096;
    const float* cst = (const float*)(F.ws + WS_CONST);
    unsigned short* Q1 = (unsigned short*)(F.ws + WS_Q1); const unsigned short* K1 = (const unsigned short*)(F.ws + WS_K1); const unsigned short* V1 = (const unsigned short*)(F.ws + WS_V1);
    for (int id = gw; id < 8192; id += NGW) {
        f32x16 o[2], lsum;
#pragma unroll
        for (int r = 0; r < 16; ++r) { o[0][r] = 0.f; o[1][r] = 0.f; lsum[r] = 0.f; }
        bf16x8 qf[4];
        const int blk = id & 255, h = (id >> 8) & 15, b = id >> 12;
        const int t0 = blk * 32; const size_t rb = (size_t)b * SEQ;
        unsigned short* Qh = Q1 + rb * 1024 + h * 64; const unsigned short* Kh = K1 + rb * 256 + (h >> 2) * 64; const unsigned short* Vh = V1 + rb * 256 + (h >> 2) * 64;
        const int tq = t0 + r32;
        load_q(qf, Qh, 1024, tq, hi);
        run_seg<false>(o, lsum, qf, Kh, Vh, 256, 0, 1, SEQ / 32, 0, 0.f, -cst[9], tq, vst, lane);
        store_o(o, lsum, 0.f, Qh, 1024, t0, 1, lane);
    }
}

struct Route { int e0, e1, pos0, pos1; float w0, w1; int pad0, pad1; };
DI void p_route(Frame& F, int layer) {
    const int gw = F.vcu * NWAVES + F.wave, NGW = F.G * NWAVES, lane = F.lane;
    const float* gwt = F.a->in[I_MGW] + (size_t)layer * 1024 * 4; const float* gb = F.a->in[I_MGB] + layer * 4;
    const float* ewt = F.a->in[I_MEW] + (size_t)layer * 4 * 1024 * 8; const float* eb = F.a->in[I_MEB] + layer * 32;
    Route* route = (Route*)(F.ws + WS_ROUTE);
    for (int m = gw; m < M; m += NGW) {
        f32x4 v[4]; load_row16(F.out + (size_t)m * D, lane, v); const float rinv = row_rinv(v);
        row_norm_store(v, rinv, F.a->in[I_FFNN] + layer * D, (bf16*)(F.ws + WS_XN) + (size_t)m * D, lane);
        float g0 = 0.f, g1 = 0.f, g2 = 0.f, g3 = 0.f;
#pragma unroll
        for (int j = 0; j < 4; ++j) { const GAS f32x4* wp = (const GAS f32x4*)gwt + (size_t)(4 * (lane + 64 * j));
#pragma unroll
            for (int c = 0; c < 4; ++c) { const f32x4 w = wp[c]; const float hv = v[j][c]; g0 += hv * w.x; g1 += hv * w.y; g2 += hv * w.z; g3 += hv * w.w; } }
        g0 = wave_sum(g0) + gb[0]; g1 = wave_sum(g1) + gb[1]; g2 = wave_sum(g2) + gb[2]; g3 = wave_sum(g3) + gb[3];
#if defined(DBG_SERIAL_ROUTER)
        {
            LAS float* hs = (LAS float*)(F.lds + RING_OFF + F.wave * 8192);
#pragma unroll
            for (int j = 0; j < 4; ++j) { hs[4 * (lane + 64 * j) + 0] = v[j].x; hs[4 * (lane + 64 * j) + 1] = v[j].y; hs[4 * (lane + 64 * j) + 2] = v[j].z; hs[4 * (lane + 64 * j) + 3] = v[j].w; }
            LDS_WAIT(); asm volatile("" ::: "memory");
            float s0 = gb[0], s1 = gb[1], s2 = gb[2], s3 = gb[3];
            for (int k = 0; k < 1024; ++k) { const float hv = hs[k]; s0 += hv * gwt[4 * k]; s1 += hv * gwt[4 * k + 1]; s2 += hv * gwt[4 * k + 2]; s3 += hv * gwt[4 * k + 3]; }
            g0 = s0; g1 = s1; g2 = s2; g3 = s3;
            LDS_WAIT(); asm volatile("" ::: "memory");
        }
#endif
        int gi = 0; float gm = g0; if (g1 > gm) { gm = g1; gi = 1; } if (g2 > gm) { gm = g2; gi = 2; } if (g3 > gm) { gm = g3; gi = 3; }
        const float pgrp = 1.0f / (expf(g0 - gm) + expf(g1 - gm) + expf(g2 - gm) + expf(g3 - gm));
        gi = __builtin_amdgcn_readfirstlane(gi);
        float e[8];
#pragma unroll
        for (int k = 0; k < 8; ++k) e[k] = 0.f;
        const float* ew = ewt + (size_t)gi * 1024 * 8;
#pragma unroll
        for (int j = 0; j < 4; ++j) { const GAS f32x4* wp = (const GAS f32x4*)ew + (size_t)(8 * (lane + 64 * j));
#pragma unroll
            for (int c = 0; c < 4; ++c) { const f32x4 wa = wp[2 * c], wb = wp[2 * c + 1]; const float hv = v[j][c];
                e[0] += hv * wa.x; e[1] += hv * wa.y; e[2] += hv * wa.z; e[3] += hv * wa.w; e[4] += hv * wb.x; e[5] += hv * wb.y; e[6] += hv * wb.z; e[7] += hv * wb.w; } }
#pragma unroll
        for (int k = 0; k < 8; ++k) e[k] = wave_sum(e[k]) + eb[gi * 8 + k];
        int i0 = 0; float m0 = e[0];
#pragma unroll
        for (int k = 1; k < 8; ++k) if (e[k] > m0) { m0 = e[k]; i0 = k; }
        int i1 = -1; float m1 = -INFINITY;
#pragma unroll
        for (int k = 0; k < 8; ++k) if (k != i0 && e[k] > m1) { m1 = e[k]; i1 = k; }
        const float t = expf(m1 - m0); const float w0 = pgrp / (1.0f + t), w1 = pgrp * t / (1.0f + t);
        if (lane == 0) {
            const int E0 = gi * 8 + i0, E1 = gi * 8 + i1;
            const int p0 = (int)__hip_atomic_fetch_add(F.ctl + CW_CNT + (layer * 32 + E0) * 64, 1u, RLX_AGENT);
            const int p1 = (int)__hip_atomic_fetch_add(F.ctl + CW_CNT + (layer * 32 + E1) * 64, 1u, RLX_AGENT);
            Route r; r.e0 = E0; r.e1 = E1; r.pos0 = p0; r.pos1 = p1; r.w0 = w0; r.w1 = w1; r.pad0 = 0; r.pad1 = 0;
            route[m] = r;
        }
    }
}
DI void build_tables(Frame& F, int layer) {
    LAS int* tstart = (LAS int*)(F.lds + LDSCTL_OFF + 1024); LAS int* tmp = (LAS int*)(F.lds + LDSCTL_OFF + 1280); LAS int* tab = (LAS int*)(F.lds + LDSCTL_OFF + 2048);
    __syncthreads();
    if (F.tid < 32) tmp[F.tid] = ((int)__hip_atomic_load(F.ctl + CW_CNT + (layer * 32 + F.tid) * 64, RLX_AGENT) + 255) >> 8;
    __syncthreads();
    if (F.tid == 0) { int acc = 0; for (int e = 0; e < 32; ++e) { tstart[e] = acc; const int n = tmp[e]; for (int t = 0; t < n; ++t) tab[1 + acc + t] = e; acc += n; } tstart[32] = acc; tab[0] = acc; }
    __syncthreads();
}
DI void p_gather(Frame& F, int layer) {
    const int gw = F.vcu * NWAVES + F.wave, NGW = F.G * NWAVES, lane = F.lane;
    build_tables(F, layer); const LAS int* tstart = (const LAS int*)(F.lds + LDSCTL_OFF + 1024);
    const Route* route = (const Route*)(F.ws + WS_ROUTE);
    float* slot_w = (float*)(F.ws + WS_ROUTE + 1 * MiB); int* tokslot = (int*)(F.ws + WS_ROUTE + 1 * MiB + 512 * 1024);
    const bf16* XN = (const bf16*)(F.ws + WS_XN); bf16* XG = (bf16*)(F.ws + WS_XG);
    for (int m = gw; m < M; m += NGW) {
        Route r;
        { const gu32* rp = (const gu32*)(route + m);
          r.e0 = (int)__hip_atomic_load(rp + 0, RLX_AGENT); r.e1 = (int)__hip_atomic_load(rp + 1, RLX_AGENT); r.pos0 = (int)__hip_atomic_load(rp + 2, RLX_AGENT); r.pos1 = (int)__hip_atomic_load(rp + 3, RLX_AGENT);
          r.w0 = __builtin_bit_cast(float, __hip_atomic_load(rp + 4, RLX_AGENT)); r.w1 = __builtin_bit_cast(float, __hip_atomic_load(rp + 5, RLX_AGENT)); }
        const int s0 = 256 * tstart[r.e0] + r.pos0, s1 = 256 * tstart[r.e1] + r.pos1;
        const GAS v4u* src = (const GAS v4u*)(XN + (size_t)m * D) + lane; const v4u a = src[0], b2 = src[64];
        GAS v4u* d0 = (GAS v4u*)(XG + (size_t)s0 * D) + lane; GAS v4u* d1 = (GAS v4u*)(XG + (size_t)s1 * D) + lane;
        d0[0] = a; d0[64] = b2; d1[0] = a; d1[64] = b2;
        if (lane == 0) { slot_w[s0] = r.w0; slot_w[s1] = r.w1; tokslot[2 * m] = s0; tokslot[2 * m + 1] = s1; }
    }
}
DI void p_combine(Frame& F, bool fin) {
    const int gw = F.vcu * NWAVES + F.wave, NGW = F.G * NWAVES, lane = F.lane;
    const int* tokslot = (const int*)(F.ws + WS_ROUTE + 1 * MiB + 512 * 1024);
    const bf16* Y = (const bf16*)(F.ws + WS_XG);
    for (int m = gw; m < M; m += NGW) {
        f32x4 v[4]; load_row16(F.out + (size_t)m * D, lane, v);
        const int s0 = (int)__hip_atomic_load((const gu32*)tokslot + 2 * m, RLX_AGENT), s1 = (int)__hip_atomic_load((const gu32*)tokslot + 2 * m + 1, RLX_AGENT);
        const GAS unsigned long long* y0 = (const GAS unsigned long long*)(Y + (size_t)s0 * D) + lane; const GAS unsigned long long* y1 = (const GAS unsigned long long*)(Y + (size_t)s1 * D) + lane;
        GAS f32x4* xo = (GAS f32x4*)(F.out + (size_t)m * D) + lane;
#pragma unroll
        for (int j = 0; j < 4; ++j) { const unsigned long long a = y0[64 * j], b2 = y1[64 * j];
            f32x4 add; add.x = bf2f((unsigned short)a) + bf2f((unsigned short)b2); add.y = bf2f((unsigned short)(a >> 16)) + bf2f((unsigned short)(b2 >> 16));
            add.z = bf2f((unsigned short)(a >> 32)) + bf2f((unsigned short)(b2 >> 32)); add.w = bf2f((unsigned short)(a >> 48)) + bf2f((unsigned short)(b2 >> 48));
            v[j] = v[j] + add; xo[64 * j] = v[j]; }
        if (!fin) { const float rinv = row_rinv(v); row_norm_store(v, rinv, F.a->in[I_MIXN] + D, (bf16*)(F.ws + WS_XN) + (size_t)m * D, lane); }
    }
}


DI void p_moe_naive(Frame& F, int layer) {
    const int gw = F.vcu * NWAVES + F.wave, NGW = F.G * NWAVES, lane = F.lane;
    LAS float* hs = (LAS float*)(F.lds + RING_OFF + F.wave * 8192); LAS float* as = hs + 1024;
    const Route* route = (const Route*)(F.ws + WS_ROUTE); const int* tokslot = (const int*)(F.ws + WS_ROUTE + 1 * MiB + 512 * 1024);
    const bf16* XN = (const bf16*)(F.ws + WS_XN); bf16* Y = (bf16*)(F.ws + WS_XG);
    for (int it = gw; it < 2 * M; it += NGW) {
        const int m = it >> 1, k = it & 1;
        const gu32* rp = (const gu32*)(route + m);
        const int E = (int)__hip_atomic_load(rp + k, RLX_AGENT); const float w = __builtin_bit_cast(float, __hip_atomic_load(rp + 4 + k, RLX_AGENT));
        const int slot = (int)__hip_atomic_load((const gu32*)tokslot + 2 * m + k, RLX_AGENT);
        for (int i = 0; i < 16; ++i) hs[lane + 64 * i] = bf2f(XN[(size_t)m * D + lane + 64 * i]);
        LDS_WAIT(); asm volatile("" ::: "memory");
        const float* Wg = F.a->in[I_WGATE] + (size_t)(layer * 32 + E) * 262144; const float* Wu = F.a->in[I_WUP] + (size_t)(layer * 32 + E) * 262144; const float* Wd = F.a->in[I_WDOWN] + (size_t)(layer * 32 + E) * 262144;
        float a[4] = {0.f, 0.f, 0.f, 0.f}, u[4] = {0.f, 0.f, 0.f, 0.f};
        for (int kk = 0; kk < 1024; ++kk) { const float hv = hs[kk];
#pragma unroll
            for (int c = 0; c < 4; ++c) { a[c] += hv * Wg[(size_t)kk * 256 + lane + 64 * c]; u[c] += hv * Wu[(size_t)kk * 256 + lane + 64 * c]; } }
#pragma unroll
        for (int c = 0; c < 4; ++c) as[lane + 64 * c] = a[c] / (1.0f + expf(-a[c])) * u[c] * w * DBG_SCALE;
        LDS_WAIT(); asm volatile("" ::: "memory");
        float y[16];
#pragma unroll
        for (int c = 0; c < 16; ++c) y[c] = 0.f;
        for (int f = 0; f < 256; ++f) { const float av = as[f];
#pragma unroll
            for (int c = 0; c < 16; ++c) y[c] += av * Wd[(size_t)f * 1024 + lane + 64 * c]; }
#pragma unroll
        for (int c = 0; c < 16; ++c) Y[(size_t)slot * D + lane + 64 * c] = (bf16)f2bf(y[c]);
        LDS_WAIT(); asm volatile("" ::: "memory");
    }
}

__global__ void __launch_bounds__(NWAVES * 64, 2) hyb_fwd(Args args) {
    extern __shared__ __attribute__((aligned(16))) unsigned char lds[];
    Frame F;
    F.lds = (LAS unsigned char*)lds;
    F.MISC = (volatile LAS unsigned*)(F.lds + MISC_OFF);
    F.tid = threadIdx.x; F.lane = F.tid & 63; F.wave = __builtin_amdgcn_readfirstlane(F.tid >> 6);
    const int wave0 = F.wave;
    F.G = gridDim.x; { const int bx = blockIdx.x; F.vcu = (F.G % 8 == 0) ? (bx % 8) * (F.G / 8) + bx / 8 : bx; }
    F.a = (KArgs)__builtin_amdgcn_kernarg_segment_ptr(); F.ws = args.ws; F.ctl = (gu32*)(args.ws + WS_CTL); F.out = args.out;
    for (int u = F.tid; u < (LDS_BYTES - LDSCTL_OFF) / 4; u += NWAVES * 64) ((LAS unsigned*)(F.lds + LDSCTL_OFF))[u] = 0u;
    __syncthreads();
    const int lo = args.ph_lo, hi = args.ph_hi;
    XcdBarrier bar; bar.bar = (unsigned*)(F.ctl + CW_BAR); bar.x = 0; bar.st = nullptr; bar.tid = 0;
    if (hi - lo > 1) bar = xcd_barrier_post((unsigned*)(F.ctl + CW_BAR), F.MISC + 8);
#ifndef PH_EN
#define PH_EN 0x7ffff
#endif
#define IN(k) (((PH_EN >> (k)) & 1) && lo <= (k) && (k) < hi)
#define SEAM(k) do { if (IN(k) && IN((k) + 1)) { XcdBarrier b2_ = bar; b2_.tid = F.tid; asm volatile("" : "+s"(b2_.bar)); xcd_barrier(b2_); } } while (0)
    bf16* XN = (bf16*)(F.ws + WS_XN);
#define PB() do { int t_ = wave0 * 64 + (int)__lane_id(); asm volatile("" : "+v"(t_)); F.tid = t_; F.lane = t_ & 63; F.wave = __builtin_amdgcn_readfirstlane(t_ >> 6); \
        KArgs a_ = (KArgs)__builtin_amdgcn_kernarg_segment_ptr(); asm volatile("" : "+s"(a_)); F.a = a_; F.ws = a_->ws; F.ctl = (gu32*)(a_->ws + WS_CTL); F.out = a_->out; XN = (bf16*)(F.ws + WS_XN); } while (0)

    if (IN(0)) { PB(); p_prologue(F); SEAM(0); }
    if (IN(1)) { PB();
        pg8::Gemm g{XN, (const bf16*)(F.ws + WS_WABIN), M, AB_PROJ, D}; pg8::StaticOrder S; S.init(M, AB_PROJ, F.G, (int)blockIdx.x);
        pg8::EpiBf16Dst<pg8::ResL0> E{pg8::ResL0{F.ws}};
        pg8::gemm_phase<pg8::EpiBf16Dst<pg8::ResL0>, pg8::StaticOrder, PG8_ALIGN, PG8_SP2>(F.lds + RING_OFF, g, S, E, F.tid);
        SEAM(1);
    }
    if (IN(2)) { PB(); p_headnorm(F, 0); SEAM(2); }
    if (IN(3)) { PB(); p_attn_l0(F); SEAM(3); }
    if (IN(4)) { PB();
        pg8::Gemm g{(const bf16*)(F.ws + WS_QAB), (const bf16*)(F.ws + WS_WABOUT), M, D, D}; pg8::StaticOrder S; S.init(M, D, F.G, (int)blockIdx.x);
        pg8::EpiResid E{F.a->in[I_X], F.out, D};
        pg8::gemm_phase<pg8::EpiResid, pg8::StaticOrder, PG8_ALIGN, PG8_SP2>(F.lds + RING_OFF, g, S, E, F.tid);
        SEAM(4);
    }
#ifndef NAIVE_MOE
#define NAIVE_MOE 0
#endif
#define MOE_BLOCK(layer, pb) do { \
        if (IN(pb)) { PB(); p_route(F, layer); SEAM(pb); } \
        if (IN((pb) + 1)) { PB(); p_gather(F, layer); SEAM((pb) + 1); } \
        if (NAIVE_MOE && IN((pb) + 2)) { PB(); p_moe_naive(F, layer); SEAM((pb) + 2); } \
        if (!NAIVE_MOE && IN((pb) + 2)) { PB(); \
            build_tables(F, layer); const LAS int* tab = (const LAS int*)(F.lds + LDSCTL_OFF + 2048); \
            pg8::Gemm g{(const bf16*)(F.ws + WS_XG), (const bf16*)(F.ws + WS_WGU) + (size_t)(layer) * (32 * 512 * 1024), SLOT_CAP, 32 * 512, D}; \
            pg8::MoeOrder<2> S{tab, F.G, (int)blockIdx.x}; \
            pg8::EpiSwiGLU E{(bf16*)(F.ws + WS_A2), (const float*)(F.ws + WS_ROUTE + 1 * MiB)}; \
            pg8::gemm_phase<pg8::EpiSwiGLU, pg8::MoeOrder<2>, PG8_ALIGN, PG8_SP2>(F.lds + RING_OFF, g, S, E, F.tid); \
            SEAM((pb) + 2); } \
        if (!NAIVE_MOE && IN((pb) + 3)) { PB(); \
            build_tables(F, layer); const LAS int* tab = (const LAS int*)(F.lds + LDSCTL_OFF + 2048); \
            pg8::Gemm g{(const bf16*)(F.ws + WS_A2), (const bf16*)(F.ws + WS_WD) + (size_t)(layer) * (32 * 1024 * 256), SLOT_CAP, 32 * 1024, DFF}; \
            pg8::MoeOrder<4> S{tab, F.G, (int)blockIdx.x}; \
            pg8::EpiBf16Dst<pg8::ResY> E{pg8::ResY{(bf16*)(F.ws + WS_XG)}}; \
            pg8::gemm_phase<pg8::EpiBf16Dst<pg8::ResY>, pg8::MoeOrder<4>, PG8_ALIGN, PG8_SP2>(F.lds + RING_OFF, g, S, E, F.tid); \
            SEAM((pb) + 3); } \
        if (IN((pb) + 4)) { PB(); p_combine(F, (layer) == 1); SEAM((pb) + 4); } } while (0)
    MOE_BLOCK(0, 5);
    if (IN(10)) { PB();
        pg8::Gemm g{XN, (const bf16*)(F.ws + WS_WCIN), M, C_PROJ, D}; pg8::StaticOrder S; S.init(M, C_PROJ, F.G, (int)blockIdx.x);
        pg8::EpiBf16Dst<pg8::ResL1> E{pg8::ResL1{F.ws}};
        pg8::gemm_phase<pg8::EpiBf16Dst<pg8::ResL1>, pg8::StaticOrder, PG8_ALIGN, PG8_SP2>(F.lds + RING_OFF, g, S, E, F.tid);
        SEAM(10);
    }
    if (IN(11)) { PB(); p_headnorm(F, 1); SEAM(11); }
    if (IN(12)) { PB(); p_attn_l1(F); SEAM(12); }
    if (IN(13)) { PB();
        pg8::Gemm g{(const bf16*)(F.ws + WS_Q1), (const bf16*)(F.ws + WS_WCOUT), M, D, D}; pg8::StaticOrder S; S.init(M, D, F.G, (int)blockIdx.x);
        pg8::EpiResid E{F.out, F.out, D};
        pg8::gemm_phase<pg8::EpiResid, pg8::StaticOrder, PG8_ALIGN, PG8_SP2>(F.lds + RING_OFF, g, S, E, F.tid);
        SEAM(13);
    }
    MOE_BLOCK(1, 14);
#undef IN
#undef SEAM
}

extern "C" void kernel_launch(void* const* d_in, const int* in_sizes, int n_in, void* d_out, int out_size, void* d_ws, size_t ws_size, hipStream_t stream) {
    static int grid = 0;
    if (grid == 0) {
        if (n_in != 21 || in_sizes[0] != M * D || out_size != M * D || ws_size < WS_END) { fprintf(stderr, "kernel_launch: unexpected shapes (n_in %d, in0 %d, out %d, ws %zu; need ws >= %zu); nothing launched\n", n_in, n_in > 0 ? in_sizes[0] : -1, out_size, ws_size, (size_t)WS_END); grid = -1; return; }
        int dev = 0, cus = 0, per_cu = 0;
        if (hipGetDevice(&dev) != hipSuccess || hipDeviceGetAttribute(&cus, hipDeviceAttributeMultiprocessorCount, dev) != hipSuccess) { grid = -1; return; }
        if (hipFuncSetAttribute((const void*)hyb_fwd, hipFuncAttributeMaxDynamicSharedMemorySize, LDS_BYTES) != hipSuccess) { fprintf(stderr, "kernel_launch: hipFuncSetAttribute failed\n"); grid = -1; return; }
        if (hipOccupancyMaxActiveBlocksPerMultiprocessor(&per_cu, (const void*)hyb_fwd, NWAVES * 64, LDS_BYTES) != hipSuccess || per_cu < 1) { fprintf(stderr, "kernel_launch: occupancy query reports %d workgroups per CU\n", per_cu); (void)hipGetLastError(); grid = -1; return; }
        grid = cus;
    }
    if (grid < 0) return;
    (void)hipMemsetAsync((char*)d_ws + WS_CTL, 0, CTL_ZERO_BYTES, stream);
    Args a{};
    for (int i = 0; i < 21; ++i) a.in[i] = (const float*)d_in[i];
    a.out = (float*)d_out; a.ws = (unsigned char*)d_ws;
#if MK_N_LAUNCHES == 1
    a.ph_lo = 0; a.ph_hi = NPHASE;
    hipLaunchKernelGGL(hyb_fwd, dim3(grid), dim3(NWAVES * 64), LDS_BYTES, stream, a);
#else
#ifndef DBG_LAST_PHASE
#define DBG_LAST_PHASE (NPHASE - 1)
#endif
    if (DBG_LAST_PHASE < 4) (void)hipMemcpyAsync(d_out, d_in[0], (size_t)M * D * 4, hipMemcpyDeviceToDevice, stream);
    for (int p = 0; p <= DBG_LAST_PHASE; ++p) { a.ph_lo = p; a.ph_hi = p + 1; hipLaunchKernelGGL(hyb_fwd, dim3(grid), dim3(NWAVES * 64), LDS_BYTES, stream, a); }
#endif
}
```

```cpp
#include <hip/hip_runtime.h>
#include <hip/hip_bf16.h>
#include <cstdio>
#include <cstdint>
#include <cmath>
#define MK_N_LAUNCHES 1
#define WCONV_IN_ATTN 1
namespace pg8 {
#define PG8_LAS __attribute__((address_space(3)))
typedef unsigned short bf16_t;
typedef short bf16x8 __attribute__((ext_vector_type(8)));
typedef float f32x4 __attribute__((ext_vector_type(4)));
typedef unsigned u32x4 __attribute__((ext_vector_type(4)));
constexpr int BM = 256, BK = 64, HALF = 128, HTB = HALF * BK * 2  , STAGE_BYTES = 8 * HTB, NXCD = 8, WGM = 8;

__host__ __device__ __forceinline__ int lds_byte(int r, int c) { const int st = (r >> 4) * 2 + (c >> 5), rr = r & 15, cc = c & 31, ob = rr * 64 + cc * 2; return st * 1024 + (ob ^ (((ob >> 9) & 1) << 5)); }
__host__ __device__ __forceinline__ void stage_rc(int b, int& R, int& C) { const int st = b / 1024, sb = b % 1024, swz = sb ^ (((sb >> 9) & 1) << 5); R = (st >> 1) * 16 + swz / 64; C = (st & 1) * 32 + (swz % 64) / 2; }
__host__ __device__ __forceinline__ int perm32(int rho) { const int n = rho >> 4, i = rho & 15; return 8 * (i >> 2) + 4 * n + (i & 3); }

struct Unit { int pm, pn, ord; };
struct Gemm { const bf16_t* A; const bf16_t* Bt; int M, N, K; };

struct StaticOrder {
    int nM, nN, nwg, G, c;
    __host__ __device__ void init(int M, int N, int G_, int c_) { nM = M / BM; nN = N / BM; nwg = nM * nN; G = G_; c = c_; }
    __host__ __device__ bool next(int i, Unit& u) const {
        const long L = (long)i * G + c; if (L >= nwg) return false;
        int wgid = (int)L; { const int q = nwg / NXCD, r = nwg % NXCD, xcd = wgid % NXCD, off = wgid / NXCD; wgid = (xcd < r ? xcd * (q + 1) : r * (q + 1) + (xcd - r) * q) + off; }
        const int nig = WGM * nN, gid = wgid / nig, fm = gid * WGM, gsz = (nM - fm) < WGM ? (nM - fm) : WGM;
        u.pm = fm + ((wgid % nig) % gsz); u.pn = (wgid % nig) / gsz; return true;
    }
    __device__ __forceinline__ void a_ready(const Unit&) const {}
    __device__ __forceinline__ void done(const Unit&) const {}
};

__device__ __forceinline__ unsigned cvt_pk_bf16(float lo, float hi) { unsigned r; asm volatile("v_cvt_pk_bf16_f32 %0, %1, %2" : "=v"(r) : "v"(lo), "v"(hi)); return r; }
typedef float f32x2 __attribute__((ext_vector_type(2)));
struct DstTile { bf16_t* p; int ldc; int c0; };
struct ResY { bf16_t* y;
    __device__ __forceinline__ DstTile operator()(int pn) const { return DstTile{y, 1024, 256 * (pn & 3)}; } };

template <class R> struct EpiBf16Dst {
    static constexpr bool PERM = true, AFTER_DRAIN = false;
    R res;
    __device__ __forceinline__ void operator()(const f32x4 (&acc)[2][2][4][2], const Unit& u, int wr, int wc, int fr, int fq) const {
        asm volatile("" : "+v"(fr), "+v"(fq));
        const DstTile d = res(u.pn);
        const int row0 = u.pm * BM + wr * 64 + fr; const int col0 = d.c0 + wc * 32 + 8 * fq;
#pragma unroll
        for (int ai = 0; ai < 2; ++ai)
#pragma unroll
            for (int m = 0; m < 4; ++m) { bf16_t* rowp = d.p + (size_t)(row0 + ai * HALF + m * 16) * d.ldc + col0;
#pragma unroll
                for (int bj = 0; bj < 2; ++bj) { const f32x4 v0 = acc[ai][bj][m][0], v1 = acc[ai][bj][m][1];
                    u32x4 w; w.x = cvt_pk_bf16(v0[0], v0[1]); w.y = cvt_pk_bf16(v0[2], v0[3]); w.z = cvt_pk_bf16(v1[0], v1[1]); w.w = cvt_pk_bf16(v1[2], v1[3]);
                    *(u32x4*)(rowp + bj * HALF) = w; } }
    }
};
struct EpiResid {
    static constexpr bool PERM = false, AFTER_DRAIN = false;
    const float* base; float* out; int ldc;
    __device__ __forceinline__ void operator()(const f32x4 (&acc)[2][2][4][2], const Unit& u, int wr, int wc, int fr, int fq) const {
        asm volatile("" : "+v"(fr), "+v"(fq));
        const int col0 = u.pn * BM + wc * 32 + 4 * fq;
#pragma unroll
        for (int ai = 0; ai < 2; ++ai)
#pragma unroll
            for (int m = 0; m < 4; ++m) { const size_t off = (size_t)(u.pm * BM + ai * HALF + wr * 64 + m * 16 + fr) * ldc + col0;
#pragma unroll
                for (int bj = 0; bj < 2; ++bj)
#pragma unroll
                    for (int n = 0; n < 2; ++n) { const f32x4 b = *(const f32x4*)(base + off + bj * HALF + n * 16); *(f32x4*)(out + off + bj * HALF + n * 16) = b + acc[ai][bj][m][n]; }
                asm volatile("" ::: "memory"); }
    }
};
__device__ __forceinline__ float silu_f(float a) { return a * __builtin_amdgcn_rcpf(1.0f + __builtin_amdgcn_exp2f(-1.4426950408889634f * a)); }
struct EpiSwiGLU {
    static constexpr bool PERM = true, AFTER_DRAIN = false;
    bf16_t* A2; const PG8_LAS float* wtab;
    __device__ __forceinline__ void operator()(const f32x4 (&acc)[2][2][4][2], const Unit& u, int wr, int wc, int fr, int fq) const {
        asm volatile("" : "+v"(fr), "+v"(fq));
        const int j = u.pn & 1; const int row0 = u.pm * BM + wr * 64 + fr; const int col0 = j * 128 + wc * 32 + 8 * fq;
#pragma unroll
        for (int ai = 0; ai < 2; ++ai)
#pragma unroll
            for (int m = 0; m < 4; ++m) { const int row = row0 + ai * HALF + m * 16; const float w = wtab[u.ord * 256 + ai * HALF + wr * 64 + m * 16 + fr];
                const f32x4 g0 = acc[ai][0][m][0], g1 = acc[ai][0][m][1], u0 = acc[ai][1][m][0], u1 = acc[ai][1][m][1];
                u32x4 o;
                o.x = cvt_pk_bf16(silu_f(g0[0]) * u0[0] * w, silu_f(g0[1]) * u0[1] * w); o.y = cvt_pk_bf16(silu_f(g0[2]) * u0[2] * w, silu_f(g0[3]) * u0[3] * w);
                o.z = cvt_pk_bf16(silu_f(g1[0]) * u1[0] * w, silu_f(g1[1]) * u1[1] * w); o.w = cvt_pk_bf16(silu_f(g1[2]) * u1[2] * w, silu_f(g1[3]) * u1[3] * w);
                bf16_t* dst_ = A2 + (size_t)row * 256 + col0;
                asm volatile("global_store_dwordx4 %0, %1, off sc1\n\ts_nop 1" :: "v"(dst_), "v"(o) : "memory"); }
    }
};
struct MoeOrderA {
    const PG8_LAS int* tab; int T, a, c;
    __device__ __forceinline__ bool next(int i, Unit& u) const {
        int tile, j;
        if (c < a) { if (i >= 2) return false; tile = T - a + c; j = i; }
        else { const int li = c - a; if (i >= 1 || li >= 2 * (T - a)) return false; tile = li >> 1; j = li & 1; }
        u.pm = tile; u.pn = __builtin_amdgcn_readfirstlane(tab[1 + tile]) * 2 + j; u.ord = i; return true;
    }
    __device__ __forceinline__ void a_ready(const Unit&) const {}
    __device__ __forceinline__ void done(const Unit&) const {}
};
struct MoeOrder2 {
    const PG8_LAS int* tab; int early, li, Lw, ne, qlate, wave; unsigned* ready;
    __device__ __forceinline__ bool next(int i, Unit& u) const {
        int q;
        if (i < ne) q = li + i * Lw; else if (i == ne && qlate >= 0) q = qlate; else return false;
        const int tile = q >> 2;
        u.pm = tile; u.pn = __builtin_amdgcn_readfirstlane(tab[1 + tile]) * 4 + (q & 3); u.ord = i; return true;
    }
    __device__ __forceinline__ void a_ready(const Unit& u) const {
        if (wave == 0) {
            for (unsigned sp = 0; sp < (1u << 21); ++sp) {
                if ((unsigned)__builtin_amdgcn_readfirstlane(__hip_atomic_load(ready + 64 * u.pm, __ATOMIC_RELAXED, __HIP_MEMORY_SCOPE_AGENT)) >= 2u) break;
                __builtin_amdgcn_s_sleep(2); }
            __builtin_amdgcn_fence(__ATOMIC_ACQUIRE, "agent");
            asm volatile("s_waitcnt vmcnt(0)" ::: "memory");
        }
        asm volatile("" ::: "memory"); __builtin_amdgcn_s_barrier(); asm volatile("" ::: "memory");
    }
    __device__ __forceinline__ void done(const Unit&) const {}
};
__device__ __forceinline__ int qkv_drow(int n0) { return (n0 & ~255) + 128 * ((n0 >> 5) & 1) + 32 * ((n0 >> 6) & 3); }
__device__ __forceinline__ float xor16_f(float v) { return __builtin_bit_cast(float, __builtin_amdgcn_ds_swizzle(__builtin_bit_cast(int, v), (16 << 10) | 0x1f)); }
__device__ __forceinline__ void halves_f(float v, float& lo, float& hi) { lo = v; hi = v; asm volatile("s_nop 1\n\tv_permlane32_swap_b32 %0, %1\n\ts_nop 1" : "+v"(lo), "+v"(hi)); }
template <int LAYER, unsigned OFF0, unsigned OFF1, unsigned OFF2, unsigned OFF3> struct EpiQKV {
    static constexpr bool PERM = true, AFTER_DRAIN = false;
    unsigned char* ws; const float* g0; const float* g1; const float* g2; const float* g3;
    const float* rtab; float c2, eps;
    __device__ __forceinline__ void operator()(const f32x4 (&acc)[2][2][4][2], const Unit& u, int wr, int wc, int fr, int fq) const {
        asm volatile("" : "+v"(fr), "+v"(fq));
        const int pn = u.pn; const float* gain = nullptr; float scale = 1.0f; bool rope = false; unsigned off; int ldc, c0;
        if (LAYER == 0) {
            if (pn < 2) { gain = g0; scale = c2; off = OFF0; ldc = 1024; c0 = 256 * pn; }
            else if (pn < 4) { gain = g1; off = OFF1; ldc = 512; c0 = 256 * (pn - 2); }
            else if (pn < 6) { off = OFF2; ldc = 512; c0 = 256 * (pn - 4); }
            else if (pn < 8) { gain = g2; scale = c2; off = OFF0; ldc = 1024; c0 = 512 + 256 * (pn - 6); }
            else { if (wc < 2) gain = g3; off = OFF3; ldc = 256; c0 = 0; }
        } else {
            if (pn < 4) { gain = g0; scale = c2; rope = true; off = OFF0; ldc = 1024; c0 = 256 * pn; }
            else if (pn == 4) { gain = g1; rope = true; off = OFF1; ldc = 256; c0 = 0; }
            else { off = OFF2; ldc = 256; c0 = 0; }
        }
        bf16_t* base = (bf16_t*)(ws + off);
        const int col0 = c0 + 64 * wc + 8 * fq;
        f32x4 gv[2][2];
        if (gain) {
#pragma unroll
            for (int bj = 0; bj < 2; ++bj)
#pragma unroll
                for (int n = 0; n < 2; ++n) gv[bj][n] = *(const f32x4*)(gain + 32 * bj + 8 * fq + 4 * n);
        }
#pragma unroll
        for (int ai = 0; ai < 2; ++ai)
#pragma unroll
            for (int m = 0; m < 4; ++m) {
                const int row = u.pm * BM + ai * HALF + wr * 64 + m * 16 + fr;
                f32x4 v[2][2];
#pragma unroll
                for (int bj = 0; bj < 2; ++bj)
#pragma unroll
                    for (int n = 0; n < 2; ++n) v[bj][n] = acc[ai][bj][m][n];
                if (gain) {
                    float ss = 0.f;
#pragma unroll
                    for (int bj = 0; bj < 2; ++bj)
#pragma unroll
                        for (int n = 0; n < 2; ++n) ss += (v[bj][n][0] * v[bj][n][0] + v[bj][n][1] * v[bj][n][1]) + (v[bj][n][2] * v[bj][n][2] + v[bj][n][3] * v[bj][n][3]);
                    ss += xor16_f(ss); { float lo, hi; halves_f(ss, lo, hi); ss = lo + hi; }
                    const float rinv = 1.0f / sqrtf(ss * (1.0f / 64.0f) + eps);
#pragma unroll
                    for (int bj = 0; bj < 2; ++bj)
#pragma unroll
                        for (int n = 0; n < 2; ++n) v[bj][n] = v[bj][n] * rinv * gv[bj][n];
                    if (rope) {
                        const int pos = row & 8191;
#pragma unroll
                        for (int bj = 0; bj < 2; ++bj) {
                            const float* t = rtab + (size_t)(bj == 0 ? (pos >> 6) : 128 + (pos & 63)) * 32 + 8 * (fq & 1);
#pragma unroll
                            for (int n = 0; n < 2; ++n) { const f32x4 cs = *(const f32x4*)(t + 4 * n), sn = *(const f32x4*)(t + 16 + 4 * n);
#pragma unroll
                                for (int i = 0; i < 4; ++i) { float lo, hi; halves_f(v[bj][n][i], lo, hi); const float y = v[bj][n][i], yp = (fq >= 2) ? lo : hi;
                                    v[bj][n][i] = (fq >= 2) ? (y * cs[i] + yp * sn[i]) : (y * cs[i] - yp * sn[i]); } }
                        }
                    }
                }
                bf16_t* rowp = base + (size_t)row * ldc + col0;
#pragma unroll
                for (int bj = 0; bj < 2; ++bj) { const f32x4 a = v[bj][0] * scale, b = v[bj][1] * scale;
                    u32x4 w; w.x = cvt_pk_bf16(a[0], a[1]); w.y = cvt_pk_bf16(a[2], a[3]); w.z = cvt_pk_bf16(b[0], b[1]); w.w = cvt_pk_bf16(b[2], b[3]);
                    *(u32x4*)(rowp + 32 * bj) = w; }
            }
    }
};
template <class Epi, class Sched, bool ALIGN_EPI = false, bool SP2 = false, bool GATHER = false>
__device__ __forceinline__ void gemm_phase(PG8_LAS unsigned char* lds, const Gemm g, const Sched& S, const Epi& E, const int tid_in, const PG8_LAS int* rowtab = nullptr) {
    static_assert(!GATHER || SP2, "GATHER is written for the SP2 loop");
    int tid_ = tid_in; asm volatile("" : "+v"(tid_));
    const int tid = tid_, wid = __builtin_amdgcn_readfirstlane(tid >> 6), lane = tid & 63, wr = wid >> 2, wc = wid & 3, fr = lane & 15, fq = lane >> 4;
    const int K = g.K, nt = K / BK;
    unsigned voffA[2], voffB[2]; int Rg[2]; unsigned Cg2[2];
#pragma unroll
    for (int i = 0; i < 2; ++i) { int R, C; stage_rc(tid * 16 + i * 8192, R, C); const int Rb = Epi::PERM ? ((R & ~31) + perm32(R & 31)) : R;
        voffA[i] = (unsigned)(R * K + C) * 2u; voffB[i] = (unsigned)(Rb * K + C) * 2u; Rg[i] = R; Cg2[i] = (unsigned)C * 2u; }
    unsigned vc[2][2], vn[2][2];
#define PG8_ROWS(V, ord) do { _Pragma("unroll") for (int _h = 0; _h < 2; ++_h) _Pragma("unroll") for (int _i = 0; _i < 2; ++_i) V[_h][_i] = (unsigned)rowtab[(ord) * 256 + _h * HALF + Rg[_i]] * (unsigned)(K * 2) + Cg2[_i]; } while (0)
#define PG8_STAGE_G(bufoff, kb, V) do { _Pragma("unroll") for (int _i = 0; _i < 2; ++_i) \
        __builtin_amdgcn_global_load_lds((const unsigned*)((const char*)g.A + (kb) + (V)[_i]), (PG8_LAS unsigned*)(lds + (bufoff) + ldsw + _i * 8192), 16, 0, 0); } while (0)
    const size_t kstep = (size_t)(BK * 2);
    const size_t hstep = (size_t)HALF * K * 2;
    const size_t tstep = 2 * hstep;
    const unsigned ldsw = (unsigned)wid * 1024u;
    const int aoff = lds_byte(wr * 64 + fr, fq * 8), boff = lds_byte(wc * 32 + fr, fq * 8);
#define PG8_SA(b, h) (((b) * 2 + (h)) * HTB)
#define PG8_SB(b, h) ((4 + (b) * 2 + (h)) * HTB)
#define PG8_STAGE(bufoff, gbase, voff) do { _Pragma("unroll") for (int _i = 0; _i < 2; ++_i) \
        __builtin_amdgcn_global_load_lds((const unsigned*)((const char*)(gbase) + (voff)[_i]), (PG8_LAS unsigned*)(lds + (bufoff) + ldsw + _i * 8192), 16, 0, 0); } while (0)
#define PG8_LDA(dst, b, h) do { _Pragma("unroll") for (int m = 0; m < 4; ++m) _Pragma("unroll") for (int k = 0; k < 2; ++k) dst[m][k] = *(const PG8_LAS bf16x8*)(lds + PG8_SA(b, h) + aoff + m * 2048 + k * 1024); } while (0)
#define PG8_LDB(dst, b, h) do { _Pragma("unroll") for (int n = 0; n < 2; ++n) _Pragma("unroll") for (int k = 0; k < 2; ++k) dst[n][k] = *(const PG8_LAS bf16x8*)(lds + PG8_SB(b, h) + boff + n * 2048 + k * 1024); } while (0)
#define PG8_MMA(ai, bj, At, Bt) do { __builtin_amdgcn_s_setprio(1); _Pragma("unroll") for (int m = 0; m < 4; ++m) _Pragma("unroll") for (int n = 0; n < 2; ++n) _Pragma("unroll") for (int k = 0; k < 2; ++k) \
        acc[ai][bj][m][n] = __builtin_amdgcn_mfma_f32_16x16x32_bf16(Bt[n][k], At[m][k], acc[ai][bj][m][n], 0, 0, 0); __builtin_amdgcn_s_setprio(0); } while (0)
#define PG8_WAIT_V(n) asm volatile("s_waitcnt vmcnt(" #n ")" ::: "memory")
#define PG8_WAIT_L(n) asm volatile("s_waitcnt lgkmcnt(" #n ")" ::: "memory")
#define PG8_BAR __builtin_amdgcn_s_barrier()
#define PG8_SCHED __builtin_amdgcn_sched_barrier(0)
    Unit cur, nxt; int ui = 0;
    if (!S.next(0, cur)) return;
    f32x4 acc[2][2][4][2];
#pragma unroll
    for (int a = 0; a < 2; ++a)
#pragma unroll
        for (int b = 0; b < 2; ++b)
#pragma unroll
            for (int m = 0; m < 4; ++m)
#pragma unroll
                for (int n = 0; n < 2; ++n) acc[a][b][m][n] = (f32x4){0.f, 0.f, 0.f, 0.f};
    bf16x8 At[4][2], B0[2][2], B1[2][2];
    const char* cA = (const char*)g.A + (size_t)cur.pm * tstep; const char* cB = (const char*)g.Bt + (size_t)cur.pn * tstep;
    S.a_ready(cur);
    if constexpr (SP2) {
        if constexpr (GATHER) { PG8_ROWS(vc, 0); }
        PG8_STAGE(PG8_SB(0, 0), cB, voffB); PG8_STAGE(PG8_SB(0, 1), cB + hstep, voffB);
        if constexpr (GATHER) { PG8_STAGE_G(PG8_SA(0, 0), 0, vc[0]); PG8_STAGE_G(PG8_SA(0, 1), 0, vc[1]); } else { PG8_STAGE(PG8_SA(0, 0), cA, voffA); PG8_STAGE(PG8_SA(0, 1), cA + hstep, voffA); }
        if (wr == 1) PG8_BAR;
        PG8_WAIT_V(2); PG8_BAR;
        PG8_STAGE(PG8_SB(1, 0), cB + kstep, voffB); if constexpr (GATHER) { PG8_STAGE_G(PG8_SA(1, 0), kstep, vc[0]); } else { PG8_STAGE(PG8_SA(1, 0), cA + kstep, voffA); } PG8_STAGE(PG8_SB(1, 1), cB + hstep + kstep, voffB);
        PG8_WAIT_V(6); PG8_BAR;
    } else {
        PG8_STAGE(PG8_SB(0, 0), cB, voffB); PG8_STAGE(PG8_SA(0, 0), cA, voffA); PG8_STAGE(PG8_SB(0, 1), cB + hstep, voffB); PG8_STAGE(PG8_SA(0, 1), cA + hstep, voffA);
        if (wr == 1) PG8_BAR;
        PG8_WAIT_V(4); PG8_BAR;
        PG8_STAGE(PG8_SB(1, 0), cB + kstep, voffB); PG8_STAGE(PG8_SA(1, 0), cA + kstep, voffA); PG8_STAGE(PG8_SB(1, 1), cB + hstep + kstep, voffB);
        PG8_WAIT_V(6); PG8_BAR;
    }
    for (;;) {
        const bool has_next = S.next(ui + 1, nxt);
        const char* nA = has_next ? (const char*)g.A + (size_t)nxt.pm * tstep : cA; const char* nB = has_next ? (const char*)g.Bt + (size_t)nxt.pn * tstep : cB;
        if constexpr (GATHER) { if (has_next) { PG8_ROWS(vn, ui + 1); } else { _Pragma("unroll") for (int _h = 0; _h < 2; ++_h) _Pragma("unroll") for (int _i = 0; _i < 2; ++_i) vn[_h][_i] = vc[_h][_i]; } }
        for (int t = 0; t < nt; t += 2) {
            const bool last = (t == nt - 2);
            const char* a1 = cA + (size_t)(t + 1) * kstep;
            const char* a2 = last ? nA : cA + (size_t)(t + 2) * kstep; const char* b2 = last ? nB : cB + (size_t)(t + 2) * kstep;
            const char* a3 = a2 + kstep; const char* b3 = b2 + kstep;
            if (last && has_next) S.a_ready(nxt);
            if constexpr (SP2) {
            unsigned w0[2], w1[2]; size_t kb2 = 0;
            if constexpr (GATHER) { kb2 = last ? (size_t)0 : (size_t)(t + 2) * kstep; _Pragma("unroll") for (int _i = 0; _i < 2; ++_i) { w0[_i] = last ? vn[0][_i] : vc[0][_i]; w1[_i] = last ? vn[1][_i] : vc[1][_i]; } }
            PG8_LDB(B0, 0, 0); PG8_LDB(B1, 0, 1); PG8_SCHED; PG8_LDA(At, 0, 0); if constexpr (GATHER) { PG8_STAGE_G(PG8_SA(1, 1), (size_t)(t + 1) * kstep, vc[1]); } else { PG8_STAGE(PG8_SA(1, 1), a1 + hstep, voffA); }
            PG8_WAIT_V(8); PG8_WAIT_L(0); PG8_BAR; PG8_MMA(0, 0, At, B0); PG8_MMA(0, 1, At, B1); PG8_BAR; PG8_SCHED;
            PG8_LDA(At, 0, 1); PG8_STAGE(PG8_SB(0, 0), b2, voffB); PG8_STAGE(PG8_SB(0, 1), b2 + hstep, voffB); if constexpr (GATHER) { PG8_STAGE_G(PG8_SA(0, 0), kb2, w0); } else { PG8_STAGE(PG8_SA(0, 0), a2, voffA); }
            PG8_WAIT_V(8); PG8_WAIT_L(0); PG8_BAR; PG8_MMA(1, 0, At, B0); PG8_MMA(1, 1, At, B1); PG8_BAR; PG8_SCHED;
            PG8_LDB(B0, 1, 0); PG8_LDB(B1, 1, 1); PG8_SCHED; PG8_LDA(At, 1, 0); if constexpr (GATHER) { PG8_STAGE_G(PG8_SA(0, 1), kb2, w1); } else { PG8_STAGE(PG8_SA(0, 1), a2 + hstep, voffA); }
            PG8_WAIT_V(8); PG8_WAIT_L(0); PG8_BAR; PG8_MMA(0, 0, At, B0); PG8_MMA(0, 1, At, B1); PG8_BAR; PG8_SCHED;
            PG8_LDA(At, 1, 1); PG8_STAGE(PG8_SB(1, 0), b3, voffB); PG8_STAGE(PG8_SB(1, 1), b3 + hstep, voffB); if constexpr (GATHER) { PG8_STAGE_G(PG8_SA(1, 0), kb2 + kstep, w0); } else { PG8_STAGE(PG8_SA(1, 0), a3, voffA); }
            PG8_WAIT_V(8); PG8_WAIT_L(0); PG8_BAR; PG8_MMA(1, 0, At, B0); PG8_MMA(1, 1, At, B1); PG8_BAR; PG8_SCHED;
            } else {
            PG8_LDB(B0, 0, 0); PG8_SCHED; PG8_LDA(At, 0, 0); PG8_STAGE(PG8_SA(1, 1), a1 + hstep, voffA);
            PG8_WAIT_L(8); PG8_BAR; PG8_WAIT_L(0); PG8_MMA(0, 0, At, B0); PG8_BAR; PG8_SCHED;
            PG8_LDB(B1, 0, 1); PG8_STAGE(PG8_SB(0, 0), b2, voffB);
            PG8_BAR; PG8_WAIT_L(0); PG8_MMA(0, 1, At, B1); PG8_BAR;
            PG8_LDA(At, 0, 1); PG8_STAGE(PG8_SA(0, 0), a2, voffA);
            PG8_BAR; PG8_WAIT_L(0); PG8_MMA(1, 0, At, B0); PG8_BAR; PG8_SCHED;
            PG8_STAGE(PG8_SB(0, 1), b2 + hstep, voffB);
            PG8_WAIT_V(6); PG8_BAR; PG8_MMA(1, 1, At, B1); PG8_BAR;
            PG8_LDB(B0, 1, 0); PG8_SCHED; PG8_LDA(At, 1, 0); PG8_STAGE(PG8_SA(0, 1), a2 + hstep, voffA);
            PG8_WAIT_L(8); PG8_BAR; PG8_WAIT_L(0); PG8_MMA(0, 0, At, B0); PG8_BAR; PG8_SCHED;
            PG8_LDB(B1, 1, 1); PG8_STAGE(PG8_SB(1, 0), b3, voffB);
            PG8_BAR; PG8_WAIT_L(0); PG8_MMA(0, 1, At, B1); PG8_BAR;
            PG8_LDA(At, 1, 1); PG8_STAGE(PG8_SA(1, 0), a3, voffA);
            PG8_BAR; PG8_WAIT_L(0); PG8_MMA(1, 0, At, B0); PG8_BAR; PG8_SCHED;
            PG8_STAGE(PG8_SB(1, 1), b3 + hstep, voffB);
            PG8_WAIT_V(6); PG8_BAR; PG8_MMA(1, 1, At, B1); PG8_BAR;
            }
        }
        if constexpr (ALIGN_EPI) { if (wr == 0) PG8_BAR; }
        if constexpr (!Epi::AFTER_DRAIN) { int le_ = tid; asm volatile("" : "+v"(le_)); E(acc, cur, wr, wc, le_ & 15, (le_ >> 4) & 3); S.done(cur); }
        if (!has_next) break;
#pragma unroll
        for (int a = 0; a < 2; ++a)
#pragma unroll
            for (int b = 0; b < 2; ++b)
#pragma unroll
                for (int m = 0; m < 4; ++m)
#pragma unroll
                    for (int n = 0; n < 2; ++n) acc[a][b][m][n] = (f32x4){0.f, 0.f, 0.f, 0.f};
        cur = nxt; cA = nA; cB = nB; ++ui;
        if constexpr (GATHER) { _Pragma("unroll") for (int _h = 0; _h < 2; ++_h) _Pragma("unroll") for (int _i = 0; _i < 2; ++_i) vc[_h][_i] = vn[_h][_i]; }
        if constexpr (ALIGN_EPI) { if (wr == 1) PG8_BAR; }
    }
    PG8_WAIT_V(0);
    if constexpr (!ALIGN_EPI) { if (wr == 0) PG8_BAR; }
    PG8_BAR;
    if constexpr (Epi::AFTER_DRAIN) { E.fused(acc, cur, wr, wc, fr, fq, lds, wid, lane); S.done(cur); }
#undef PG8_ROWS
#undef PG8_STAGE_G
#undef PG8_SA
#undef PG8_SB
#undef PG8_STAGE
#undef PG8_LDA
#undef PG8_LDB
#undef PG8_MMA
#undef PG8_WAIT_V
#undef PG8_WAIT_L
#undef PG8_BAR
#undef PG8_SCHED
}
}

#ifndef DBG_REPEAT_PHASE
#define DBG_REPEAT_PHASE (-1)
#endif
#ifndef PG8_SP2
#define PG8_SP2 true
#endif
#ifndef PG8_ALIGN
#define PG8_ALIGN true
#endif
#ifndef MK_N_LAUNCHES
#define MK_N_LAUNCHES 1
#endif
constexpr int NWAVES = 8;
constexpr int BATCH = 2, SEQ = 8192, D = 1024, M = BATCH * SEQ;
constexpr int HD = 64;
constexpr int AB_PROJ = 2304, C_PROJ = 1536;
constexpr int NEXP = 32, DFF = 256;
constexpr int SLOT_CAP = 40960;
constexpr float RMS_EPS = 1e-6f;
constexpr float LOG2E = 1.4426950408889634f;
constexpr float C2 = 0.125f * LOG2E;
constexpr int NPHASE = 19;

constexpr size_t MiB = 1u << 20;
constexpr size_t WS_CTL = 0, CTL_ZERO_BYTES = 1 * MiB;
constexpr size_t WS_CONST = 1 * MiB;
constexpr size_t WS_WABIN = 2 * MiB, WS_WABOUT = 7 * MiB, WS_WCIN = 9 * MiB, WS_WCOUT = 12 * MiB;
constexpr size_t WS_WGU = 14 * MiB;
constexpr size_t WS_WD = 78 * MiB;
constexpr size_t WS_XN = 110 * MiB;
constexpr size_t WS_ROUTE = 142 * MiB;
constexpr size_t WS_P = 144 * MiB;
constexpr size_t WS_QAB = WS_P, WS_KA = WS_P + 32 * MiB, WS_VA = WS_P + 48 * MiB, WS_KVB = WS_P + 64 * MiB;
constexpr size_t WS_O0 = WS_P + 72 * MiB;
constexpr size_t WS_O1 = WS_P + 48 * MiB;
constexpr size_t WS_Q1 = WS_P, WS_K1 = WS_P + 32 * MiB, WS_V1 = WS_P + 40 * MiB;
constexpr size_t WS_XG = WS_P, WS_A2 = WS_P + 80 * MiB;
constexpr size_t WS_LIST = WS_P + 100 * MiB;
constexpr size_t WS_END = WS_LIST + 4 * MiB;
static_assert((size_t)SLOT_CAP * 1024 * 2 == 80 * MiB && (size_t)SLOT_CAP * 256 * 2 == 20 * MiB, "slot buffers");
constexpr int CW_TMO = 0;
constexpr int CW_BAR = 4096;
constexpr int CW_CNT = 16384;
constexpr int CW_RDY = 20480;

constexpr int RING_OFF = 0, RING_BYTES = 131072;
constexpr int LDSCTL_OFF = RING_BYTES, MISC_OFF = LDSCTL_OFF + 320;
constexpr int LDS_BYTES = 147456;
#define GAS __attribute__((address_space(1)))
#define LAS __attribute__((address_space(3)))
typedef unsigned short bf16;
typedef unsigned v4u __attribute__((ext_vector_type(4)));
typedef float f32x4 __attribute__((ext_vector_type(4)));
typedef short bf16x8 __attribute__((ext_vector_type(8)));
typedef GAS unsigned gu32;
typedef GAS unsigned long long gu64;
#define RLX_AGENT __ATOMIC_RELAXED, __HIP_MEMORY_SCOPE_AGENT
#define LDS_WAIT() asm volatile("s_waitcnt lgkmcnt(0)" ::: "memory")
#define VM_WAIT() asm volatile("s_waitcnt vmcnt(0)" ::: "memory")
__device__ __forceinline__ unsigned long long rt() { return __builtin_amdgcn_s_memrealtime(); }
__device__ __forceinline__ unsigned f2bf(float f) { unsigned u = __builtin_bit_cast(unsigned, f); return (u + 0x7fffu + ((u >> 16) & 1u)) >> 16; }
__device__ __forceinline__ unsigned pk2(float lo, float hi) { return f2bf(lo) | (f2bf(hi) << 16); }
#define XB_TMO      128
#define XB_XCNT(j)  (256  + 64 * (j))
#define XB_XSUB(j)  (1280 + 64 * (j))
#define XB_XGEN(j)  (2304 + 64 * (j))
#define XB_TOP      3328
#define XB_TOPGEN   3392
#define XCD_BAR_WORDS 3456
#define XB_SPIN_CAP (1u << 18)

__device__ __forceinline__ unsigned xb_ld(unsigned* p)              { return __hip_atomic_load(p, __ATOMIC_RELAXED, __HIP_MEMORY_SCOPE_AGENT); }
__device__ __forceinline__ unsigned xb_add(unsigned* p, unsigned v) { return __hip_atomic_fetch_add(p, v, __ATOMIC_RELAXED, __HIP_MEMORY_SCOPE_AGENT); }
__device__ __forceinline__ unsigned xb_xcc_id() { return (unsigned)__builtin_amdgcn_s_getreg((3 << 11) | 20) & 0xFu; }
#define XB_SPIN(cond, bar) do { unsigned _sp = 0; while (cond) { __builtin_amdgcn_s_sleep(1); \
    if ((++_sp & 255u) == 0u) { if (xb_ld(&(bar)[XB_TMO])) break; if (_sp > XB_SPIN_CAP) { atomicAdd(&(bar)[XB_TMO], 1u); break; } } } } while (0)

struct XcdBarrier {
    unsigned* bar; unsigned x; int tid;
    volatile LAS unsigned* st;
};

__device__ __forceinline__ XcdBarrier xcd_barrier_post(unsigned* bar, volatile LAS unsigned* st) {
    XcdBarrier b; b.bar = bar; b.x = xb_xcc_id(); b.st = st;
    if (threadIdx.x == 0) (void)xb_add(&bar[XB_XCNT(b.x)], 1u);
    return b;
}
__device__ __forceinline__ void xcd_barrier_complete(unsigned* bar, unsigned x, unsigned& nloc, unsigned& nx) {
    const unsigned G = gridDim.x * gridDim.y * gridDim.z;
    unsigned sum, cnt, mine, sp = 0u;
    for (;;) {
        sum = 0u; cnt = 0u; mine = 0u;
#pragma unroll
        for (unsigned j = 0; j < 16; ++j) { const unsigned c = xb_ld(&bar[XB_XCNT(j)]); sum += c; cnt += (c > 0u) ? 1u : 0u; mine = (j == x) ? c : mine; }
        if (sum == G) break;
        __builtin_amdgcn_s_sleep(1);
        if ((++sp & 255u) == 0u) { if (xb_ld(&bar[XB_TMO])) break; if (sp > XB_SPIN_CAP) { atomicAdd(&bar[XB_TMO], 1u); break; } }
    }
    nloc = mine > 0u ? mine : 1u; nx = cnt > 0u ? cnt : 1u;
}

__device__ __forceinline__ void xcd_barrier(const XcdBarrier& b) {
    asm volatile("s_waitcnt vmcnt(0)" ::: "memory");
    __syncthreads();
    if (b.tid == 0) {
        unsigned* bar = b.bar;
        __builtin_amdgcn_s_waitcnt(0);
        unsigned nloc = b.st[0], nx = b.st[1];
        if (nloc == 0u) { xcd_barrier_complete(bar, b.x, nloc, nx); b.st[0] = nloc; b.st[1] = nx; }
        const unsigned old = xb_add(&bar[XB_XSUB(b.x)], 1u);
        const unsigned gen = old / nloc;
        if (old + 1u == (gen + 1u) * nloc) {
            __builtin_amdgcn_fence(__ATOMIC_RELEASE, "agent");
            asm volatile("s_waitcnt vmcnt(0)" ::: "memory");
            const unsigned og = xb_add(&bar[XB_TOP], 1u);
            const unsigned tg = og / nx;
            if (og + 1u == (tg + 1u) * nx) xb_add(&bar[XB_TOPGEN], 1u);
            else XB_SPIN(xb_ld(&bar[XB_TOPGEN]) == tg, bar);
            __builtin_amdgcn_fence(__ATOMIC_ACQUIRE, "agent");
            xb_add(&bar[XB_XGEN(b.x)], 1u);
            asm volatile("s_waitcnt vmcnt(0)" ::: "memory");
        } else {
            XB_SPIN(xb_ld(&bar[XB_XGEN(b.x)]) == gen, bar);
            __builtin_amdgcn_fence(__ATOMIC_ACQUIRE, "agent");
            asm volatile("s_waitcnt vmcnt(0)" ::: "memory");
        }
    }
    __syncthreads();
}
#include <hip/hip_bf16.h>
#include <cmath>
namespace attn_body {
using bf16=__hip_bfloat16;
using bf16x8=__attribute__((ext_vector_type(8)))short;
using s16x4=__attribute__((ext_vector_type(4)))short;
using f32x16=__attribute__((ext_vector_type(16)))float;
using u32x4=__attribute__((ext_vector_type(4)))unsigned;
constexpr int BATCH=2,NHEAD=16,SEQ=8192,D=64,DM=NHEAD*D,KVP=256,GRP=4;
constexpr int NW=8,QBLK=32,QB=QBLK*NW,KVBLK=64,NQB=SEQ/QB;
constexpr int ATTN_PITCH=DM, ATTN_UNIT_ROWS=QB;
__device__ __forceinline__ int crow(int r,int hi){return (r&3)+8*(r>>2)+4*hi;}
#define SBAR() __builtin_amdgcn_sched_barrier(0)
__device__ __forceinline__ void cmask(f32x16&p0,f32x16&p1,int jb,int qrel,int hi){
  const float NEG=-INFINITY; int kb=64*jb+4*hi;
  #pragma unroll
  for(int r=0;r<16;++r){int kv=kb+(r&3)+8*(r>>2); if(kv>qrel)p0[r]=NEG; if(kv+32>qrel)p1[r]=NEG;}
}

constexpr int NSLOT=3, SLOTB=8192;
constexpr int LDS_K=0, LDS_V=NSLOT*SLOTB, LDS_WS=2*NSLOT*SLOTB, LDS_OST=LDS_WS+NW*64*4, LDS_BYTES=LDS_OST+NW*4096;
constexpr float C2=0.125f*1.4426950408889634f;
__device__ __forceinline__ void glds16(const void*gsrc,unsigned lds_dst){unsigned keep;
  asm volatile("s_mov_b32 %0, m0\n\ts_mov_b32 m0, %2\n\ts_nop 0\n\tglobal_load_lds_dwordx4 %1, off\n\ts_mov_b32 m0, %0":"=&s"(keep):"v"(gsrc),"s"(lds_dst):"memory");}
__device__ __forceinline__ float max3f(float a,float b,float c){float r;asm("v_max3_f32 %0, %1, %2, %3":"=v"(r):"v"(a),"v"(b),"v"(c));return r;}
__device__ __forceinline__ float max2f(float a,float b){float r;asm("v_max_f32_e32 %0, %1, %2":"=v"(r):"v"(a),"v"(b));return r;}
__device__ __forceinline__ float fadd_s(float a,float b){float r;asm("v_add_f32_e32 %0, %1, %2":"=v"(r):"v"(a),"v"(b));return r;}
__device__ __forceinline__ float fsub_s(float a,float b){float r;asm("v_sub_f32_e32 %0, %1, %2":"=v"(r):"v"(a),"v"(b));return r;}
typedef float f32x2_t __attribute__((ext_vector_type(2))); typedef __bf16 bf16x2_t __attribute__((ext_vector_type(2)));
__device__ __forceinline__ unsigned cvtpk_s(float lo,float hi){f32x2_t v={lo,hi};bf16x2_t b=__builtin_convertvector(v,bf16x2_t);return __builtin_bit_cast(unsigned,b);}
#define WAIT_BAR(N) asm volatile("s_waitcnt vmcnt(" #N ") lgkmcnt(0)\n\ts_barrier":::"memory")

__device__ __forceinline__ void qkt(f32x16&p0,f32x16&p1,const char*Kslot,const bf16x8*qr,const f32x16&negm,int r32,int hi){
  const char*kb=Kslot+hi*1024+r32*16;
  #pragma unroll
  for(int d0=0;d0<4;++d0){
    const bf16x8 b0=*reinterpret_cast<const bf16x8*>(kb+d0*2048);
    const bf16x8 b1=*reinterpret_cast<const bf16x8*>(kb+d0*2048+512);
    if(d0==0){p0=__builtin_amdgcn_mfma_f32_32x32x16_bf16(b0,qr[0],negm,0,0,0);p1=__builtin_amdgcn_mfma_f32_32x32x16_bf16(b1,qr[0],negm,0,0,0);}
    else{p0=__builtin_amdgcn_mfma_f32_32x32x16_bf16(b0,qr[d0],p0,0,0,0);p1=__builtin_amdgcn_mfma_f32_32x32x16_bf16(b1,qr[d0],p1,0,0,0);}}
}
typedef __attribute__((address_space(3))) const char* lds_cptr;
typedef short v4i16_t __attribute__((ext_vector_type(4)));
__device__ __forceinline__ void kload8(bf16x8*kf,lds_cptr kp){
  kf[0]=*(const __attribute__((address_space(3))) bf16x8*)(kp);      kf[1]=*(const __attribute__((address_space(3))) bf16x8*)(kp+512);
  kf[2]=*(const __attribute__((address_space(3))) bf16x8*)(kp+2048); kf[3]=*(const __attribute__((address_space(3))) bf16x8*)(kp+2560);
  kf[4]=*(const __attribute__((address_space(3))) bf16x8*)(kp+4096); kf[5]=*(const __attribute__((address_space(3))) bf16x8*)(kp+4608);
  kf[6]=*(const __attribute__((address_space(3))) bf16x8*)(kp+6144); kf[7]=*(const __attribute__((address_space(3))) bf16x8*)(kp+6656);
}
__device__ __forceinline__ void kload2(bf16x8*kf,lds_cptr kp,int j){ kf[2*j]=*(const __attribute__((address_space(3))) bf16x8*)(kp+j*2048); kf[2*j+1]=*(const __attribute__((address_space(3))) bf16x8*)(kp+j*2048+512); }
__device__ __forceinline__ s16x4 vtr(lds_cptr p){ return __builtin_bit_cast(s16x4,__builtin_amdgcn_ds_read_tr16_b64_v4i16((__attribute__((address_space(3))) v4i16_t*)p)); }
__device__ __forceinline__ float rowmax(const f32x16&p0,const f32x16&p1){
  float a=max3f(p0[0],p0[1],p1[0]),b=max3f(p0[2],p0[3],p1[1]);a=max3f(a,p1[2],p1[3]);
  #pragma unroll
  for(int r=4;r<16;r+=4){a=max3f(a,p0[r],p0[r+1]);b=max3f(b,p0[r+2],p0[r+3]);a=max3f(a,p1[r],p1[r+1]);b=max3f(b,p1[r+2],p1[r+3]);}
  const float m=max2f(a,b);
  auto rr=__builtin_amdgcn_permlane32_swap(__float_as_uint(m),__float_as_uint(m),false,false);
  return max2f(__uint_as_float(rr[0]),__uint_as_float(rr[1]));
}
__device__ __forceinline__ void pv(f32x16*o,int vb,bf16x8 pa0,bf16x8 pa1,bf16x8 pa2,bf16x8 pa3){
  #pragma unroll
  for(int d0=0;d0<2;++d0){s16x4 lo[4],hi[4];
    #pragma unroll
    for(int ks=0;ks<4;++ks){
      asm volatile("ds_read_b64_tr_b16 %0,%1 offset:%c2":"=&v"(lo[ks]):"v"(vb),"i"(d0*4096+ks*1024):"memory");
      asm volatile("ds_read_b64_tr_b16 %0,%1 offset:%c2":"=&v"(hi[ks]):"v"(vb),"i"(d0*4096+ks*1024+512):"memory");}
    asm volatile("s_waitcnt lgkmcnt(0)":::"memory");SBAR();
    #define PK(k) (bf16x8){lo[k][0],lo[k][1],lo[k][2],lo[k][3],hi[k][0],hi[k][1],hi[k][2],hi[k][3]}
    o[d0]=__builtin_amdgcn_mfma_f32_32x32x16_bf16(pa0,PK(0),o[d0],0,0,0);
    o[d0]=__builtin_amdgcn_mfma_f32_32x32x16_bf16(pa1,PK(1),o[d0],0,0,0);
    o[d0]=__builtin_amdgcn_mfma_f32_32x32x16_bf16(pa2,PK(2),o[d0],0,0,0);
    o[d0]=__builtin_amdgcn_mfma_f32_32x32x16_bf16(pa3,PK(3),o[d0],0,0,0);
    #undef PK
  }
}

#ifndef ATTN_STORE16
#define ATTN_STORE16(p,v) (*(u32x4*)(p)=(v))
#endif
struct NoHook { int mode=0; __device__ __forceinline__ void begin_unit(){} __device__ __forceinline__ void issue(int){} __device__ __forceinline__ void consume(int){} __device__ __forceinline__ void advance(bool){} };
template<int THRL,class Hook> __device__ __forceinline__ void attn_unit(int b,int h,int qb,const bf16*Q,const bf16*__restrict__ K,const bf16*__restrict__ V,bf16*O,char*shm,const int tid_in,const float Mref,Hook&hk){
  const int tid=tid_in,lane=tid&63,r32=lane&31,hi=lane>>5; const int wid=__builtin_amdgcn_readfirstlane(tid>>6);
  const long rowbase=(long)b*SEQ; const int q0=qb*QB;
  const bf16*Qw=Q+(rowbase+q0+wid*QBLK)*DM+h*D;
  const bf16*Kh=K+rowbase*KVP+(h/GRP)*D,*Vh=V+rowbase*KVP+(h/GRP)*D;
  const unsigned lds0=(unsigned)(uintptr_t)shm;
  float*wsf=(float*)(shm+LDS_WS)+wid*64;
  const bf16*ksrc=Kh+(long)lane*KVP+wid*8;
  const bf16*vsrc=Vh+(long)(16*(wid&3)+(lane>>2))*KVP+(wid>>2)*32+(lane&3)*8;
  const unsigned kdst=lds0+LDS_K+wid*1024, vdst=lds0+LDS_V+wid*1024;
  #define DMA_K(t,slot) glds16(ksrc+(long)(t)*KVBLK*KVP,(unsigned)__builtin_amdgcn_readfirstlane(kdst+(slot)))
  #define DMA_V(t,slot) glds16(vsrc+(long)(t)*KVBLK*KVP,(unsigned)__builtin_amdgcn_readfirstlane(vdst+(slot)))
  const int vb0=(int)(lds0+LDS_V)+((lane>>4)&1)*32+(lane&3)*8+(4*hi+((lane&15)>>2))*64;
  const char*Kbase=shm+LDS_K; bf16x8 kf[8];
  const lds_cptr shm3=(lds_cptr)shm; const lds_cptr kp0=shm3+LDS_K+hi*1024+r32*16; const lds_cptr vp0=shm3+LDS_V+((lane>>4)&1)*32+(lane&3)*8+(4*hi+((lane&15)>>2))*64;
  const int NT=SEQ/KVBLK;
  DMA_K(0,0);DMA_V(0,0);DMA_K(1,SLOTB);
  bf16x8 qr[4];
  #pragma unroll
  for(int d0=0;d0<4;++d0)qr[d0]=*reinterpret_cast<const bf16x8*>(&Qw[(long)r32*DM+d0*16+hi*8]);
  float l_reg=0.f;f32x16 o[2];o[0]=f32x16{};o[1]=f32x16{};f32x16 negm;
  _Pragma("unroll") for(int r=0;r<16;++r)negm[r]=-Mref;asm volatile("":"+v"(negm));
  const int qrel=wid*QBLK+r32;
  #define CMASK(P0,P1,t) do{}while(0)
  #define START(P0,P1) do{ _Pragma("unroll") for(int r=0;r<16;++r)P0[r]=__builtin_amdgcn_exp2f(P0[r]); }while(0)
  #define RESC() do{}while(0)
  f32x16 pA0,pA1,pB0,pB1;
  int sl_prev=0,sl_cur=0,sl_next=SLOTB;
  #define ROT() do{sl_prev=sl_cur;sl_cur=sl_next;sl_next=(sl_next==(NSLOT-1)*SLOTB)?0:sl_next+SLOTB;}while(0)
  DMA_K(2,2*SLOTB);
  WAIT_BAR(3);
  qkt(pA0,pA1,Kbase,qr,negm,r32,hi);asm volatile("s_nop 15\n\ts_nop 7":"+v"(pA0),"+v"(pA1));CMASK(pA0,pA1,0);
  START(pA0,pA1);
  _Pragma("unroll") for(int r=0;r<16;++r)pA1[r]=__builtin_amdgcn_exp2f(pA1[r]);
  WAIT_BAR(0);
  DMA_K(3,0);DMA_V(1,SLOTB);
  ROT();
  kload8(kf,kp0+sl_cur);
  WAIT_BAR(2);
  s16x4 vlo[8],vhi[8]; u32x4 pw0,pw1,pw2,pw3;
  #define PKW(P,B) cvtpk_s(P[B],P[B+1])
  #define PAF(k) __builtin_bit_cast(bf16x8,pw##k)
  #define VFR(i) (bf16x8){vlo[i][0],vlo[i][1],vlo[i][2],vlo[i][3],vhi[i][0],vhi[i][1],vhi[i][2],vhi[i][3]}
  #define PIN(x) asm volatile("":"+v"(x))
  #define MX3(a,b,c) __builtin_fmaxf(__builtin_fmaxf((a),(b)),(c))
  #define GAPA(MF,A0,A1,A2,A3,W0,W1,PW) do{ MF; sacc+=A0; sacc+=A1; sacc+=A2; sacc+=A3; PIN(sacc); W0; W1; PIN(PW); SBAR(); }while(0)
  #define EX(v) __builtin_amdgcn_exp2f(v)
  #define GAPB(MF,X,B) do{ MF; X[B]=EX(X[B]); X[B+1]=EX(X[B+1]); X[B+2]=EX(X[B+2]); X[B+3]=EX(X[B+3]); PIN(X); SBAR(); }while(0)
  #define VRD(i) do{ vlo[i]=vtr(vp_+(((i)>>2)*4096+((i)&3)*1024)); vhi[i]=vtr(vp_+(((i)>>2)*4096+((i)&3)*1024+512)); }while(0)
  #define KRD(G,j) do{ if(G){ kload2(kf,kp0+sl_next,j); SBAR(); } }while(0)
  #define STEP(C0,C1,P0,P1,t,GK,GV,GL,HK) do{ SBAR(); \
    const lds_cptr vp_=vp0+sl_prev; \
    VRD(0); SBAR(); float sacc=(P0[0]+P0[1]); \
    GAPA(C0=__builtin_amdgcn_mfma_f32_32x32x16_bf16(kf[0],qr[0],negm,0,0,0), P0[2],P0[3],P0[4],P0[5],     pw0[0]=PKW(P0,0), pw0[1]=PKW(P0,2), pw0); \
    VRD(4); SBAR(); GAPA(C1=__builtin_amdgcn_mfma_f32_32x32x16_bf16(kf[1],qr[0],negm,0,0,0), P0[6],P0[7],P0[8],P0[9],     pw0[2]=PKW(P0,4), pw0[3]=PKW(P0,6), pw0); \
    VRD(1); SBAR(); GAPA(C0=__builtin_amdgcn_mfma_f32_32x32x16_bf16(kf[2],qr[1],C0,0,0,0),   P0[10],P0[11],P0[12],P0[13], pw1[0]=PKW(P0,8), pw1[1]=PKW(P0,10), pw1); \
    VRD(5); SBAR(); GAPA(C1=__builtin_amdgcn_mfma_f32_32x32x16_bf16(kf[3],qr[1],C1,0,0,0),   P0[14],P0[15],P1[0],P1[1],   pw1[2]=PKW(P0,12),pw1[3]=PKW(P0,14), pw1); \
    VRD(2); SBAR(); GAPA(C0=__builtin_amdgcn_mfma_f32_32x32x16_bf16(kf[4],qr[2],C0,0,0,0),   P1[2],P1[3],P1[4],P1[5],     pw2[0]=PKW(P1,0), pw2[1]=PKW(P1,2), pw2); \
    VRD(6); SBAR(); GAPA(C1=__builtin_amdgcn_mfma_f32_32x32x16_bf16(kf[5],qr[2],C1,0,0,0),   P1[6],P1[7],P1[8],P1[9],     pw2[2]=PKW(P1,4), pw2[3]=PKW(P1,6), pw2); \
    VRD(3); SBAR(); GAPA(C0=__builtin_amdgcn_mfma_f32_32x32x16_bf16(kf[6],qr[3],C0,0,0,0),   P1[10],P1[11],P1[12],P1[13], pw3[0]=PKW(P1,8), pw3[1]=PKW(P1,10), pw3); \
    VRD(7); SBAR(); GAPA(C1=__builtin_amdgcn_mfma_f32_32x32x16_bf16(kf[7],qr[3],C1,0,0,0),   P1[14],P1[15],0.f,0.f,       pw3[2]=PKW(P1,12),pw3[3]=PKW(P1,14), pw3); \
    l_reg+=sacc; \
    if(GK){DMA_K((t)+3,sl_cur);} if(GV){DMA_V((t)+1,sl_next);} if(HK){ if(hk.mode==1) hk.issue(lane); } \
    CMASK(C0,C1,t); \
    SBAR(); \
    GAPB(o[0]=__builtin_amdgcn_mfma_f32_32x32x16_bf16(PAF(0),VFR(0),o[0],0,0,0), C0,0); \
    GAPB(o[1]=__builtin_amdgcn_mfma_f32_32x32x16_bf16(PAF(0),VFR(4),o[1],0,0,0), C0,4); \
    KRD(GL,0); GAPB(o[0]=__builtin_amdgcn_mfma_f32_32x32x16_bf16(PAF(1),VFR(1),o[0],0,0,0), C0,8); \
    KRD(GL,1); GAPB(o[1]=__builtin_amdgcn_mfma_f32_32x32x16_bf16(PAF(1),VFR(5),o[1],0,0,0), C0,12); \
    KRD(GL,2); GAPB(o[0]=__builtin_amdgcn_mfma_f32_32x32x16_bf16(PAF(2),VFR(2),o[0],0,0,0), C1,0); \
    KRD(GL,3); GAPB(o[1]=__builtin_amdgcn_mfma_f32_32x32x16_bf16(PAF(2),VFR(6),o[1],0,0,0), C1,4); \
    GAPB(o[0]=__builtin_amdgcn_mfma_f32_32x32x16_bf16(PAF(3),VFR(3),o[0],0,0,0), C1,8); \
    GAPB(o[1]=__builtin_amdgcn_mfma_f32_32x32x16_bf16(PAF(3),VFR(7),o[1],0,0,0), C1,12); \
    }while(0)
  int t=1;
  #undef CMASK
  #define CMASK(P0,P1,t) do{}while(0)
  hk.begin_unit();
  for(;t+5<NT&&hk.mode!=0;t+=2){
    STEP(pB0,pB1,pA0,pA1,t,true,true,true,1);     if(hk.mode==1){WAIT_BAR(6);}else{WAIT_BAR(2);} RESC(); ROT();
    if(hk.mode==2) hk.consume(lane);
    STEP(pA0,pA1,pB0,pB1,t+1,true,true,true,0);   if(hk.mode==1){WAIT_BAR(6);}else{WAIT_BAR(2);} RESC(); ROT();
    hk.advance(t+9<NT);
  }
  for(;t+5<NT;t+=2){
    STEP(pB0,pB1,pA0,pA1,t,true,true,true,0);     WAIT_BAR(2); RESC(); ROT();
    STEP(pA0,pA1,pB0,pB1,t+1,true,true,true,0);   WAIT_BAR(2); RESC(); ROT();
  }
  #undef CMASK
  #define CMASK(P0,P1,t) do{}while(0)
  #define ENDW(tt) do{ if((tt)+3<NT){WAIT_BAR(2);} else if((tt)+2<NT){WAIT_BAR(1);} else {WAIT_BAR(0);} }while(0)
  for(;t+1<NT;t+=2){
    STEP(pB0,pB1,pA0,pA1,t,(t+3<NT),(t+1<NT),(t+1<NT),0);       ENDW(t);   RESC(); ROT();
    STEP(pA0,pA1,pB0,pB1,t+1,(t+4<NT),(t+2<NT),(t+2<NT),0);     ENDW(t+1); RESC(); ROT();
  }
  STEP(pB0,pB1,pA0,pA1,NT-1,false,false,false,0); RESC();
  { float sacc=pB0[0]+pB0[1]; _Pragma("unroll") for(int r=2;r<16;++r)sacc+=pB0[r]; _Pragma("unroll") for(int r=0;r<16;++r)sacc+=pB1[r]; l_reg+=sacc;
    pw0=(u32x4){PKW(pB0,0),PKW(pB0,2),PKW(pB0,4),PKW(pB0,6)};pw1=(u32x4){PKW(pB0,8),PKW(pB0,10),PKW(pB0,12),PKW(pB0,14)};pw2=(u32x4){PKW(pB1,0),PKW(pB1,2),PKW(pB1,4),PKW(pB1,6)};pw3=(u32x4){PKW(pB1,8),PKW(pB1,10),PKW(pB1,12),PKW(pB1,14)};
    SBAR(); pv(o,vb0+sl_cur,PAF(0),PAF(1),PAF(2),PAF(3)); }
  #undef PKW
  #undef PAF
  #undef VFR
  #undef PIN
  #undef MX3
  #undef GAPA
  #undef GAPB
  #undef EX
  #undef VRD
  #undef KRD
  #undef STEP
  #undef ENDW
  {auto rr=__builtin_amdgcn_permlane32_swap(__float_as_uint(l_reg),__float_as_uint(l_reg),false,false);l_reg=__uint_as_float(rr[0])+__uint_as_float(rr[1]);}
  if(hi==0)wsf[32+r32]=l_reg;asm volatile("s_waitcnt lgkmcnt(0)":::"memory");
  float rli[16];
  #pragma unroll
  for(int r=0;r<16;++r)rli[r]=__builtin_amdgcn_rcpf(wsf[32+crow(r,hi)]);
  bf16*Ow=O+(rowbase+q0+wid*QBLK)*DM+h*D;
  { bf16*stg=(bf16*)(shm+LDS_OST)+wid*2048;
    #pragma unroll
    for(int r=0;r<16;++r){const int orow=crow(r,hi);
      #pragma unroll
      for(int d0=0;d0<2;++d0)stg[orow*64+d0*32+r32]=__float2bfloat16(o[d0][r]*rli[r]);}
    asm volatile("s_waitcnt lgkmcnt(0)":::"memory");
    #pragma unroll
    for(int i=0;i<4;++i){const int row=i*8+(lane>>3),ch=lane&7; const u32x4 v=*(const u32x4*)(stg+row*64+ch*8); ATTN_STORE16(Ow+(long)row*DM+ch*8,v);} }
  asm volatile("s_waitcnt lgkmcnt(0)\n\ts_barrier":::"memory");
  #undef DMA_K
  #undef DMA_V
  #undef CMASK
  #undef START
  #undef RESC
  #undef ROT
}
constexpr int ATTN_LDS_BYTES=LDS_BYTES;
struct AttnTensors { const bf16* Q; const bf16* K; const bf16* V; bf16* O; float Mref; };
struct AttnUnit { int bh; int qb; };
struct StaticOrder {
  int vcu;
  __device__ __forceinline__ explicit StaticOrder(int grid,int block):vcu((block%8)*(grid/8)+block/8){}
  __device__ __forceinline__ bool next(int i,AttnUnit&u)const{ if(i>=4)return false; const int s=vcu&7; u.bh=vcu>>3; u.qb=(i==0)?s:(i==1)?15-s:(i==2)?16+s:31-s; return true; }
  __device__ __forceinline__ void a_ready(const AttnUnit&)const{}
  __device__ __forceinline__ void done(const AttnUnit&)const{}
};
template<class Sched,int THRL=8> __device__ __forceinline__ void attn_phase(char*lds,const AttnTensors&T,const Sched&S,const int tid_in){
  AttnUnit u;
  NoHook nh; for(int i=0;S.next(i,u);++i){ S.a_ready(u); attn_unit<THRL,NoHook>(u.bh/NHEAD,u.bh%NHEAD,u.qb,T.Q,T.K,T.V,T.O,lds,tid_in,T.Mref,nh); S.done(u); }
}
#undef SBAR
#undef WAIT_BAR
}

namespace pg8 { typedef EpiQKV<0, (unsigned)WS_QAB, (unsigned)WS_KA, (unsigned)WS_VA, (unsigned)WS_KVB> EpiQKV0; typedef EpiQKV<1, (unsigned)WS_Q1, (unsigned)WS_K1, (unsigned)WS_V1, 0u> EpiQKV1; }
#define DI __device__ __forceinline__
struct Args { const float* in[21]; float* out; unsigned char* ws; int ph_lo, ph_hi; };
typedef const __attribute__((address_space(4))) Args* KArgs;
struct Frame {
    LAS unsigned char* lds;
    volatile LAS unsigned* MISC;
    gu32* ctl;
    int tid, lane, wave, vcu, G;
    unsigned char* ws;
    KArgs a;
    float* out;
};
enum { I_X = 0, I_MIXN, I_FFNN, I_ABWIN, I_AQN, I_AKN, I_BQN, I_BKN, I_BSINK, I_ABWOUT, I_CWIN, I_CQN, I_CKN, I_CWOUT, I_MGW, I_MGB, I_MEW, I_MEB, I_WGATE, I_WUP, I_WDOWN };

template <int PAT> DI float swz_f(float v) { return __builtin_bit_cast(float, __builtin_amdgcn_ds_swizzle(__builtin_bit_cast(int, v), PAT)); }
template <int CTRL> DI float dpp_f(float v) { return __builtin_bit_cast(float, __builtin_amdgcn_update_dpp(0, __builtin_bit_cast(int, v), CTRL, 0xf, 0xf, true)); }
DI float xor1_f(float v) { return dpp_f<0xB1>(v); }
DI float xor2_f(float v) { return dpp_f<0x4E>(v); }
DI float wave_sum(float v) {
    v += xor1_f(v); v += xor2_f(v);
    v += dpp_f<0x141>(v);
    v += dpp_f<0x140>(v);
    const float s0 = __builtin_bit_cast(float, __builtin_amdgcn_readlane(__builtin_bit_cast(int, v), 0)), s1 = __builtin_bit_cast(float, __builtin_amdgcn_readlane(__builtin_bit_cast(int, v), 16));
    const float s2 = __builtin_bit_cast(float, __builtin_amdgcn_readlane(__builtin_bit_cast(int, v), 32)), s3 = __builtin_bit_cast(float, __builtin_amdgcn_readlane(__builtin_bit_cast(int, v), 48));
    return (s0 + s1) + (s2 + s3);
}
DI float bf2f(unsigned short b) { return __builtin_bit_cast(float, (unsigned)b << 16); }

DI void tr_item(const float* W, int N, bf16* WT, int dstK, int drow, LAS float* scr, int k0, int n0, int lane) {
    const int r8 = lane >> 3, c4 = (lane & 7) * 4;
    f32x4 v[8];
#pragma unroll
    for (int i = 0; i < 8; ++i) v[i] = __builtin_nontemporal_load((const GAS f32x4*)(W + (size_t)(k0 + 8 * i + r8) * N + n0 + c4));
#pragma unroll
    for (int i = 0; i < 8; ++i) { LAS float* d = scr + (8 * i + r8) * 33 + c4; d[0] = v[i].x; d[1] = v[i].y; d[2] = v[i].z; d[3] = v[i].w; }
    LDS_WAIT(); asm volatile("" ::: "memory");
    const int c = lane & 7;
#pragma unroll
    for (int j = 0; j < 4; ++j) { const int n = (lane >> 3) + 8 * j; const LAS float* s = scr + (8 * c) * 33 + n;
        v4u o; o.x = pk2(s[0 * 33], s[1 * 33]); o.y = pk2(s[2 * 33], s[3 * 33]); o.z = pk2(s[4 * 33], s[5 * 33]); o.w = pk2(s[6 * 33], s[7 * 33]);
        *(GAS v4u*)(WT + (size_t)(drow + n) * dstK + k0 + 8 * c) = o; }
    LDS_WAIT(); asm volatile("" ::: "memory");
}
DI void load_row16(const float* row, int lane, f32x4 (&v)[4]) {
    const GAS f32x4* xr = (const GAS f32x4*)row + lane;
#pragma unroll
    for (int j = 0; j < 4; ++j) v[j] = xr[64 * j];
}
DI float row_rinv(const f32x4 (&v)[4]) {
    float s = 0.f;
#pragma unroll
    for (int j = 0; j < 4; ++j) s += (v[j].x * v[j].x + v[j].y * v[j].y) + (v[j].z * v[j].z + v[j].w * v[j].w);
    return 1.0f / sqrtf(wave_sum(s) * (1.f / D) + RMS_EPS);
}
DI void row_norm_store(f32x4 (&v)[4], float rinv, const float* g, bf16* orow, int lane) {
    const GAS f32x4* gr = (const GAS f32x4*)g + lane;
    GAS unsigned long long* o8 = (GAS unsigned long long*)orow + lane;
#pragma unroll
    for (int j = 0; j < 4; ++j) { const f32x4 gg = gr[64 * j]; v[j] = v[j] * rinv * gg;
        o8[64 * j] = (unsigned long long)pk2(v[j].x, v[j].y) | ((unsigned long long)pk2(v[j].z, v[j].w) << 32); }
}
DI void row_norm_store_g(f32x4 (&v)[4], float rinv, const f32x4 (&gg)[4], bf16* orow, int lane) {
    GAS unsigned long long* o8 = (GAS unsigned long long*)orow + lane;
#pragma unroll
    for (int j = 0; j < 4; ++j) { v[j] = v[j] * rinv * gg[j];
        o8[64 * j] = (unsigned long long)pk2(v[j].x, v[j].y) | ((unsigned long long)pk2(v[j].z, v[j].w) << 32); }
}
#ifndef WCONV_IN_ATTN
#define WCONV_IN_ATTN 1
#endif
constexpr int MOE_WITEMS_ALL = 3 * 64 * 128;
constexpr int MOE_WITEMS = WCONV_IN_ATTN ? MOE_WITEMS_ALL / 2 : 0;
DI void moe_weight_item(Frame& F, int r, LAS float* scr) {
    constexpr int IE = 64 * 128;
    if (r < 2 * IE) {
        const int up = r >= IE ? 1 : 0; r -= up * IE;
        const int mat = r >> 7, itx = r & 127, kb = itx >> 3, nb = itx & 7, l = mat >> 5, E = mat & 31, n0 = 32 * nb;
        const float* src = F.a->in[up ? I_WUP : I_WGATE] + (size_t)mat * 262144;
        bf16* dst = (bf16*)(F.ws + WS_WGU) + (size_t)l * (32 * 512 * 1024);
        tr_item(src, 256, dst, 1024, E * 512 + (n0 >> 7) * 256 + (n0 & 127) + up * 128, scr, 64 * kb, n0, F.lane);
    } else {
        r -= 2 * IE;
        const int mat = r >> 7, itx = r & 127, kb = itx >> 5, nb = itx & 31, l = mat >> 5, E = mat & 31, n0 = 32 * nb;
        const float* src = F.a->in[I_WDOWN] + (size_t)mat * 262144;
        bf16* dst = (bf16*)(F.ws + WS_WD) + (size_t)l * (32 * 1024 * 256);
        tr_item(src, 1024, dst, 256, E * 1024 + n0, scr, 64 * kb, n0, F.lane);
    }
}
struct WHalf { const float* src; bf16* dst; int N, dstK, drow, k0, n0; };
constexpr int WSUB_L = MOE_WITEMS_ALL;
DI WHalf moe_weight_half(Frame& F, int sub) {
    constexpr int IE = 64 * 128; WHalf d; int r = sub >> 1; const int kh = sub & 1;
    if (r < 2 * IE) {
        const int up = r >= IE ? 1 : 0; r -= up * IE;
        const int mat = r >> 7, itx = r & 127, kb = itx >> 3, nb = itx & 7, l = mat >> 5, E = mat & 31, n0 = 32 * nb;
        d.src = F.a->in[up ? I_WUP : I_WGATE] + (size_t)mat * 262144; d.dst = (bf16*)(F.ws + WS_WGU) + (size_t)l * (32 * 512 * 1024);
        d.N = 256; d.dstK = 1024; d.drow = E * 512 + (n0 >> 7) * 256 + (n0 & 127) + up * 128; d.k0 = 64 * kb + 32 * kh; d.n0 = n0;
    } else {
        r -= 2 * IE;
        const int mat = r >> 7, itx = r & 127, kb = itx >> 5, nb = itx & 31, l = mat >> 5, E = mat & 31, n0 = 32 * nb;
        d.src = F.a->in[I_WDOWN] + (size_t)mat * 262144; d.dst = (bf16*)(F.ws + WS_WD) + (size_t)l * (32 * 1024 * 256);
        d.N = 1024; d.dstK = 256; d.drow = E * 1024 + n0; d.k0 = 64 * kb + 32 * kh; d.n0 = n0;
    }
    return d;
}
DI int witem_of_layer(int l, int j) { return ((j >> 12) << 13) + (l << 12) + (j & 4095); }
DI int wsub_of_layer(int l, int j) { return 2 * witem_of_layer(l, j >> 1) + (j & 1); }
constexpr int WH_BLK = 1088, WH_SCR_BYTES = 4 * WH_BLK;
DI void wh_glds16(const void* gsrc, unsigned lds_dst) { unsigned keep;
    asm volatile("s_mov_b32 %0, m0\n\ts_mov_b32 m0, %2\n\ts_nop 0\n\tglobal_load_lds_dwordx4 %1, off nt\n\ts_mov_b32 m0, %0" : "=&s"(keep) : "v"(gsrc), "s"(lds_dst) : "memory"); }
DI void wh_issue(const WHalf& d, int lane, unsigned scr_lds) {
    const float* p = d.src + (size_t)(d.k0 + (lane >> 3)) * d.N + d.n0 + (lane & 7) * 4;
#pragma unroll
    for (int i = 0; i < 4; ++i) wh_glds16(p + (size_t)(8 * i) * d.N, scr_lds + i * WH_BLK);
}
DI void wh_finish(const WHalf& d, int lane, const LAS float* scr) {
    const int c = lane & 3;
#pragma unroll
    for (int j = 0; j < 2; ++j) { const int n = (lane >> 2) + 16 * j; const LAS float* s = scr + c * (WH_BLK / 4) + n;
        v4u o; o.x = pk2(s[0 * 32], s[1 * 32]); o.y = pk2(s[2 * 32], s[3 * 32]); o.z = pk2(s[4 * 32], s[5 * 32]); o.w = pk2(s[6 * 32], s[7 * 32]);
        *(GAS v4u*)(d.dst + (size_t)(d.drow + n) * d.dstK + d.k0 + 8 * c) = o; }
    LDS_WAIT(); asm volatile("" ::: "memory");
}
constexpr int WS_PER_UNIT = 3;
struct DenseWStream {
    Frame* F; int j, stride, left, mode; LAS float* scr; unsigned scr_lds;
    DI void begin_unit() { left = WS_PER_UNIT; mode = (WCONV_IN_ATTN && j < WSUB_L) ? 1 : 0; }
    DI void issue(int lane) { asm volatile("" : "+v"(lane));     const WHalf wd = moe_weight_half(*F, wsub_of_layer(1, j)); wh_issue(wd, lane, scr_lds); }
    DI void consume(int lane) { asm volatile("" : "+v"(lane)); const WHalf wd = moe_weight_half(*F, wsub_of_layer(1, j)); wh_finish(wd, lane, scr); j += stride; --left; }
    DI void advance(bool can_start) { mode = mode == 1 ? 2 : ((left > 0 && j < WSUB_L && can_start) ? 1 : 0); }
};
DI void p_prologue(Frame& F) {
    LAS float* scr = (LAS float*)(F.lds + RING_OFF + F.wave * 16384);
    const int gw = F.vcu * NWAVES + F.wave, NGW = F.G * NWAVES;
    constexpr int I0 = 16 * 72, I1 = 16 * 32, I2 = 16 * 48, I3 = 16 * 32;
    constexpr int NITEMS = I0 + I1 + I2 + I3;
    for (int it = gw; it < NITEMS; it += NGW) {
        int r = it;
        if (r < I0) { tr_item(F.a->in[I_ABWIN], AB_PROJ, (bf16*)(F.ws + WS_WABIN), 1024, pg8::qkv_drow(32 * (r % 72)), scr, 64 * (r / 72), 32 * (r % 72), F.lane); continue; } r -= I0;
        if (r < I1) { tr_item(F.a->in[I_ABWOUT], 1024, (bf16*)(F.ws + WS_WABOUT), 1024, 32 * (r % 32), scr, 64 * (r / 32), 32 * (r % 32), F.lane); continue; } r -= I1;
        if (r < I2) { tr_item(F.a->in[I_CWIN], C_PROJ, (bf16*)(F.ws + WS_WCIN), 1024, pg8::qkv_drow(32 * (r % 48)), scr, 64 * (r / 48), 32 * (r % 48), F.lane); continue; } r -= I2;
        tr_item(F.a->in[I_CWOUT], 1024, (bf16*)(F.ws + WS_WCOUT), 1024, 32 * (r % 32), scr, 64 * (r / 32), 32 * (r % 32), F.lane);
    }
    if (!WCONV_IN_ATTN) for (int it = gw; it < MOE_WITEMS_ALL; it += NGW) moe_weight_item(F, it, scr);
    float* cst = (float*)(F.ws + WS_CONST);
    {
        const int gt = (F.vcu * NWAVES + F.wave) * 64 + F.lane;
        if (gt < 3072) {
            const int isc = gt >= 2048 ? 1 : 0, e = isc ? gt - 2048 : gt, pos = e >> 4, i = e & 15;
            const float invf = exp2f(-(float)(2 * i) * (1.0f / 32.0f) * 13.287712379549449f);
            const float ang = (float)pos * invf;
            float* t = cst + 1024 + (isc ? 4096 : 0) + (size_t)pos * 32 + i;
            t[0] = cosf(ang); t[16] = sinf(ang);
        }
        if (gt == 4096) {
            float aq = 0.f, ak = 0.f, bq = 0.f, bk = 0.f, cq = 0.f, ck = 0.f;
            for (int i = 0; i < 64; ++i) { aq = fmaxf(aq, fabsf(F.a->in[I_AQN][i])); ak = fmaxf(ak, fabsf(F.a->in[I_AKN][i])); bq = fmaxf(bq, fabsf(F.a->in[I_BQN][i]));
                bk = fmaxf(bk, fabsf(F.a->in[I_BKN][i])); cq = fmaxf(cq, fabsf(F.a->in[I_CQN][i])); ck = fmaxf(ck, fabsf(F.a->in[I_CKN][i])); }
            cst[0] = 8.0f * aq * ak * LOG2E * 1.02f;
            const float mb = 8.0f * bq * bk * LOG2E * 1.02f;
            for (int h = 0; h < 8; ++h) cst[1 + h] = fmaxf(mb, F.a->in[I_BSINK][h] * LOG2E);
            cst[9] = 8.0f * cq * ck * LOG2E * 1.02f;
        }
    }
    {
        f32x4* rt = (f32x4*)(F.ws + WS_CONST + 65536);
        for (int idx = (F.vcu * NWAVES + F.wave) * 64 + F.lane; idx < 2 * 9216; idx += F.G * NWAVES * 64) {
            const int L = idx / 9216, r = idx % 9216;
            if (r < 1024) { const int l = r & 63, jc = r >> 6, k = 4 * (l + 64 * (jc >> 2)) + (jc & 3); rt[idx] = ((const f32x4*)(F.a->in[I_MGW] + (size_t)L * 4096))[k]; }
            else { const int q = r - 1024, g = q >> 11, t = q & 2047, l = t & 63, hh = (t >> 6) & 1, jc = t >> 7, k = 4 * (l + 64 * (jc >> 2)) + (jc & 3);
                rt[idx] = ((const f32x4*)(F.a->in[I_MEW] + (size_t)(L * 4 + g) * 8192))[2 * k + hh]; }
        }
    }
    {
        f32x4 gg[4]; { const GAS f32x4* gr = (const GAS f32x4*)F.a->in[I_MIXN] + F.lane;
#pragma unroll
            for (int j = 0; j < 4; ++j) gg[j] = gr[64 * j]; }
        for (int m = gw; m < M; m += 4 * NGW) {
            f32x4 v[4][4];
#pragma unroll
            for (int i = 0; i < 4; ++i) if (m + i * NGW < M) load_row16(F.a->in[I_X] + (size_t)(m + i * NGW) * D, F.lane, v[i]);
#pragma unroll
            for (int i = 0; i < 4; ++i) if (m + i * NGW < M) { const float rinv = row_rinv(v[i]); row_norm_store_g(v[i], rinv, gg, (bf16*)(F.ws + WS_XN) + (size_t)(m + i * NGW) * D, F.lane); }
        }
    }
}

namespace att {
using bf16x8 = __attribute__((ext_vector_type(8))) short;
using s16x4 = __attribute__((ext_vector_type(4))) short;
using f32x16 = __attribute__((ext_vector_type(16))) float;
using u32x4 = __attribute__((ext_vector_type(4))) unsigned;
typedef __attribute__((address_space(3))) const char* lds_cptr;
typedef short v4i16_t __attribute__((ext_vector_type(4)));
typedef float f32x2_t __attribute__((ext_vector_type(2))); typedef __bf16 bf16x2_t __attribute__((ext_vector_type(2)));
DI int crow(int r, int hi) { return (r & 3) + 8 * (r >> 2) + 4 * hi; }
DI s16x4 vtr(lds_cptr p) { return __builtin_bit_cast(s16x4, __builtin_amdgcn_ds_read_tr16_b64_v4i16((__attribute__((address_space(3))) v4i16_t*)p)); }
DI unsigned cvtpk(float lo, float hi) { f32x2_t v = {lo, hi}; bf16x2_t b = __builtin_convertvector(v, bf16x2_t); return __builtin_bit_cast(unsigned, b); }
#define MFMA32(a, b, c) __builtin_amdgcn_mfma_f32_32x32x16_bf16((a), (b), (c), 0, 0, 0)

DI void load_q(bf16x8 (&qf)[4], const unsigned short* Q, int qpitch, int tq, int hi) {
    const unsigned short* qp = Q + (size_t)tq * qpitch + 8 * hi;
#pragma unroll
    for (int d0 = 0; d0 < 4; ++d0) qf[d0] = *(const bf16x8*)(qp + 16 * d0);
}
}

namespace att {
template <int NSUB, bool EDGE>
DI void band_run_t(f32x16 (&o)[2], f32x16& lsum, const bf16x8 (&qf)[4], const unsigned short* Kb, const unsigned short* Vb, const int kvpitch,
                   const int ktok0, const int dil, const float slope2d, const float negM, LAS unsigned char* vst, const int lane) {
    constexpr int HALFW = 16 * (NSUB - 1), SMID = (NSUB - 1) / 2;
    int ln_ = lane; asm volatile("" : "+v"(ln_));
    const int r32 = ln_ & 31, hi = ln_ >> 5;
    const lds_cptr vrd = (lds_cptr)vst + ((ln_ >> 4) & 1) * 32 + (ln_ & 3) * 8 + (4 * hi + ((ln_ & 15) >> 2)) * 64;
    const short one = (short)0x3F80; const bf16x8 ones = {one, one, one, one, one, one, one, one};
    bf16x8 kf[2][4]; u32x4 vv[2][4];
    const size_t sstep = (size_t)(32 * dil) * kvpitch;
    const unsigned short* kp0 = Kb + (ptrdiff_t)(ktok0 + dil * r32) * kvpitch + 8 * hi;
    const unsigned short* vp0 = Vb + (ptrdiff_t)(ktok0 + dil * (ln_ >> 2)) * kvpitch + (ln_ & 3) * 8;
    const unsigned short* vp1 = vp0 + (size_t)(16 * dil) * kvpitch;
    const unsigned short* kpr = kp0; const unsigned short* vpr0 = vp0; const unsigned short* vpr1 = vp1;
#define BAND_LOAD(s_, b_) do { if (EDGE) { \
        int tk_ = ktok0 + dil * (32 * (s_) + r32); tk_ = tk_ < 0 ? 0 : (tk_ > SEQ - 1 ? SEQ - 1 : tk_); \
        const unsigned short* kp_ = Kb + (size_t)tk_ * kvpitch + 8 * hi; \
        _Pragma("unroll") for (int d0 = 0; d0 < 4; ++d0) kf[b_][d0] = *(const bf16x8*)(kp_ + 16 * d0); \
        _Pragma("unroll") for (int pc = 0; pc < 4; ++pc) { int tv_ = ktok0 + dil * (32 * (s_) + 16 * (pc & 1) + (ln_ >> 2)); tv_ = tv_ < 0 ? 0 : (tv_ > SEQ - 1 ? SEQ - 1 : tv_); \
            vv[b_][pc] = *(const u32x4*)(Vb + (size_t)tv_ * kvpitch + (pc >> 1) * 32 + (ln_ & 3) * 8); } \
      } else { const unsigned short* kp_ = kpr; const unsigned short* va_ = vpr0; const unsigned short* vb_ = vpr1; kpr += sstep; vpr0 += sstep; vpr1 += sstep; asm volatile("" : "+v"(kpr), "+v"(vpr0), "+v"(vpr1)); \
        _Pragma("unroll") for (int d0 = 0; d0 < 4; ++d0) kf[b_][d0] = *(const bf16x8*)(kp_ + 16 * d0); \
        vv[b_][0] = *(const u32x4*)(va_); vv[b_][2] = *(const u32x4*)(va_ + 32); vv[b_][1] = *(const u32x4*)(vb_); vv[b_][3] = *(const u32x4*)(vb_ + 32); } } while (0)
    BAND_LOAD(0, 0);
    const float fq = (float)(4 * hi - HALFW - r32);
#pragma unroll
    for (int s = 0; s < NSUB; ++s) {
        const int cur = s & 1;
        float fqs = fq; int r32s = r32; asm volatile("" : "+v"(fqs), "+v"(r32s));
        if (s + 1 < NSUB) BAND_LOAD(s + 1, cur ^ 1);
        asm volatile("" ::: "memory");
#pragma unroll
        for (int pc = 0; pc < 4; ++pc) *(LAS u32x4*)(vst + pc * 1024 + ln_ * 16) = vv[cur][pc];
        f32x16 p;
        if (s == SMID) {
#pragma unroll
            for (int r = 0; r < 16; ++r) p[r] = __builtin_fmaf(-slope2d, __builtin_fabsf(fqs + (float)(32 * s + (r & 3) + 8 * (r >> 2))), negM);
        } else {
            float sl = s < SMID ? slope2d : -slope2d; asm volatile("" : "+v"(sl)); const float pb = __builtin_fmaf(sl, fqs, negM);
#pragma unroll
            for (int r = 0; r < 16; ++r) p[r] = __builtin_fmaf(sl, (float)(32 * s + (r & 3) + 8 * (r >> 2)), pb);
        }
#pragma unroll
        for (int d0 = 0; d0 < 4; ++d0) p = MFMA32(kf[cur][d0], qf[d0], p);
        if (s == 0) {
#pragma unroll
            for (int r = 0; r < 16; ++r) if (crow(r, hi) < r32s) p[r] = -INFINITY;
        }
        if (s == NSUB - 1) {
#pragma unroll
            for (int r = 0; r < 16; ++r) if (crow(r, hi) > r32s) p[r] = -INFINITY;
        }
        if (EDGE) {
#pragma unroll
            for (int r = 0; r < 16; ++r) { const int tok = ktok0 + dil * (32 * s + crow(r, hi)); if (tok < 0 || tok >= SEQ) p[r] = -INFINITY; }
        }
#pragma unroll
        for (int r = 0; r < 16; ++r) p[r] = __builtin_amdgcn_exp2f(p[r]);
        u32x4 w0, w1;
        w0.x = cvtpk(p[0], p[1]); w0.y = cvtpk(p[2], p[3]); w0.z = cvtpk(p[4], p[5]); w0.w = cvtpk(p[6], p[7]);
        w1.x = cvtpk(p[8], p[9]); w1.y = cvtpk(p[10], p[11]); w1.z = cvtpk(p[12], p[13]); w1.w = cvtpk(p[14], p[15]);
        const bf16x8 pa0 = __builtin_bit_cast(bf16x8, w0), pa1 = __builtin_bit_cast(bf16x8, w1);
        asm volatile("" ::: "memory");
#pragma unroll
        for (int s2 = 0; s2 < 2; ++s2)
#pragma unroll
            for (int d0 = 0; d0 < 2; ++d0) { const s16x4 lo4 = vtr(vrd + d0 * 2048 + s2 * 1024), hi4 = vtr(vrd + d0 * 2048 + s2 * 1024 + 512);
                const bf16x8 vb = {lo4[0], lo4[1], lo4[2], lo4[3], hi4[0], hi4[1], hi4[2], hi4[3]};
                o[d0] = MFMA32(s2 ? pa1 : pa0, vb, o[d0]); }
        lsum = MFMA32(pa0, ones, lsum); lsum = MFMA32(pa1, ones, lsum);
        asm volatile("" ::: "memory");
    }
#undef BAND_LOAD
}
template <int NSUB>
DI void band_run(f32x16 (&o)[2], f32x16& lsum, const bf16x8 (&qf)[4], const unsigned short* Kb, const unsigned short* Vb, const int kvpitch,
                 const int ktok0, const int dil, const float slope2d, const float negM, LAS unsigned char* vst, const int lane) {
    const bool edge = (ktok0 < 0) || (ktok0 + dil * (32 * NSUB - 1) >= SEQ);
    if (edge) band_run_t<NSUB, true>(o, lsum, qf, Kb, Vb, kvpitch, ktok0, dil, slope2d, negM, vst, lane);
    else band_run_t<NSUB, false>(o, lsum, qf, Kb, Vb, kvpitch, ktok0, dil, slope2d, negM, vst, lane);
}
DI void part_store(const f32x16 (&o)[2], const f32x16& lsum, LAS unsigned short* ptab, LAS float* ltab, int a, int st, int lane) {
    int ln_ = lane; asm volatile("" : "+v"(ln_)); const int r32 = ln_ & 31, hi = ln_ >> 5;
#pragma unroll
    for (int r = 0; r < 16; ++r) { const int idx = a + st * crow(r, hi); ptab[idx * 64 + r32] = (unsigned short)f2bf(o[0][r]); ptab[idx * 64 + 32 + r32] = (unsigned short)f2bf(o[1][r]); if (r32 == 0) ltab[idx] = lsum[r]; }
}
DI void part_load(f32x16 (&o)[2], f32x16& lsum, const LAS unsigned short* ptab, const LAS float* ltab, int a, int st, int lane) {
    int ln_ = lane; asm volatile("" : "+v"(ln_)); const int r32 = ln_ & 31, hi = ln_ >> 5;
#pragma unroll
    for (int r = 0; r < 16; ++r) { const int idx = a + st * crow(r, hi); o[0][r] = bf2f(ptab[idx * 64 + r32]); o[1][r] = bf2f(ptab[idx * 64 + 32 + r32]); lsum[r] = ltab[idx]; }
}
DI void store_o_rows(const f32x16 (&o)[2], const f32x16& lsum, float lextra, unsigned short* Orow0, int opitch, LAS unsigned char* vst, int lane) {
    int ln_ = lane; asm volatile("" : "+v"(ln_)); const int r32 = ln_ & 31, hi = ln_ >> 5; LAS unsigned short* stg = (LAS unsigned short*)vst;
    asm volatile("" ::: "memory");
#pragma unroll
    for (int r = 0; r < 16; ++r) { const float inv = 1.0f / (lsum[r] + lextra); const int q = crow(r, hi); stg[q * 64 + r32] = (unsigned short)f2bf(o[0][r] * inv); stg[q * 64 + 32 + r32] = (unsigned short)f2bf(o[1][r] * inv); }
    asm volatile("s_waitcnt lgkmcnt(0)" ::: "memory");
#pragma unroll
    for (int i = 0; i < 4; ++i) { const int row = i * 8 + (ln_ >> 3), ch = ln_ & 7; const u32x4 v = *(const LAS u32x4*)(stg + row * 64 + ch * 8); *(u32x4*)(Orow0 + (size_t)row * opitch + ch * 8) = v; }
    asm volatile("s_waitcnt lgkmcnt(0)" ::: "memory");
}
}

DI void p_attn_l0(Frame& F) {
    using namespace att;
    const int lane = F.lane, r32 = lane & 31, hi = lane >> 5, wave = F.wave;
    LAS unsigned char* vst = F.lds + RING_OFF + wave * 4096;
    LAS unsigned short* ptab = (LAS unsigned short*)(F.lds + RING_OFF + 32768);
    LAS float* ltab = (LAS float*)(F.lds + RING_OFF + 98304);
    LAS float* scr = (LAS float*)(F.lds + RING_OFF + 32768 + wave * 8704);
    const float* cst = (const float*)(F.ws + WS_CONST);
    const unsigned short* QAB = (const unsigned short*)(F.ws + WS_QAB); const unsigned short* KA = (const unsigned short*)(F.ws + WS_KA); const unsigned short* VA = (const unsigned short*)(F.ws + WS_VA);
    const unsigned short* KVB = (const unsigned short*)(F.ws + WS_KVB); unsigned short* O0 = (unsigned short*)(F.ws + WS_O0);
    const int NGW = F.G * NWAVES; int wit = F.vcu * NWAVES + wave;
    for (int unit = F.vcu; unit < 256; unit += F.G) {
        const int span = unit & 15, h = (unit >> 4) & 7, b = unit >> 7, base = span * 512; const size_t rb = (size_t)b * SEQ;
        f32x16 o[2], lsum; bf16x8 qf[4];
        for (int rpa_ = 0; rpa_ < (DBG_REPEAT_PHASE == 31 ? 2 : 1); ++rpa_)
        {
            const unsigned short* Qh = QAB + rb * 1024 + h * 64; const unsigned short* Kh = KA + rb * 512 + h * 64; const unsigned short* Vh = VA + rb * 512 + h * 64;
            const float slope2 = exp2f(-0.5f * (float)(2 * h + 1)) * LOG2E, negM = -cst[0];
#pragma unroll 1
            for (int pass = 0; pass < 3; ++pass) {
                const int dil = pass == 0 ? 16 : (pass == 1 ? 4 : 1);
#pragma unroll 1
                for (int task = wave; task < 16; task += NWAVES) {
                    const int a = pass == 0 ? task : (pass == 1 ? (task & 3) + 128 * (task >> 2) : 32 * task);
                    load_q(qf, Qh, 1024, base + a + dil * r32, hi);
                    if (pass == 0) {
#pragma unroll
                        for (int r = 0; r < 16; ++r) { o[0][r] = 0.f; o[1][r] = 0.f; lsum[r] = 0.f; }
                    } else part_load(o, lsum, ptab, ltab, a, dil, lane);
                    band_run<5>(o, lsum, qf, Kh, Vh, 512, base + a - 64 * dil, dil, slope2 * (float)dil, negM, vst, lane);
                    if (pass < 2) part_store(o, lsum, ptab, ltab, a, dil, lane);
                    else store_o_rows(o, lsum, 0.f, O0 + (rb + base + a) * 1024 + h * 64, 1024, vst, lane);
                }
                if (pass < 2) __syncthreads();
            }
            __syncthreads();
        }
        for (int rpb_ = 0; rpb_ < (DBG_REPEAT_PHASE == 32 ? 2 : 1); ++rpb_)
        {
            const unsigned short* Qh = QAB + rb * 1024 + 512 + h * 64; const unsigned short* Kh = KVB + rb * 256 + (h >> 2) * 64; const unsigned short* Vh = KVB + rb * 256 + 128 + (h >> 2) * 64;
            const float Mh = cst[1 + h], slope2 = exp2f(-(float)(h + 1)) * LOG2E, lextra = exp2f(F.a->in[I_BSINK][h] * LOG2E - Mh);
            for (int task = wave; task < 16; task += NWAVES) {
                if (wave < 4) for (int n = 0; n < 3 && wit < MOE_WITEMS; ++n, wit += NGW) moe_weight_item(F, witem_of_layer(0, wit), scr);
                const int a = 32 * task;
                load_q(qf, Qh, 1024, base + a + r32, hi);
#pragma unroll
                for (int r = 0; r < 16; ++r) { o[0][r] = 0.f; o[1][r] = 0.f; lsum[r] = 0.f; }
                band_run<9>(o, lsum, qf, Kh, Vh, 256, base + a - 128, 1, slope2, -Mh, vst, lane);
                store_o_rows(o, lsum, lextra, O0 + (rb + base + a) * 1024 + 512 + h * 64, 1024, vst, lane);
                if (wave >= 4) for (int n = 0; n < 3 && wit < MOE_WITEMS; ++n, wit += NGW) moe_weight_item(F, witem_of_layer(0, wit), scr);
            }
            __syncthreads();
        }
    }
    for (; wit < MOE_WITEMS; wit += NGW) moe_weight_item(F, witem_of_layer(0, wit), scr);
}
struct Route { int e0, e1, pos0, pos1; float w0, w1; int pad0, pad1; };
DI void p_route(Frame& F, int layer) {
    const int gw = F.vcu * NWAVES + F.wave, NGW = F.G * NWAVES, lane = F.lane;
    const float* gb = F.a->in[I_MGB] + layer * 4; const float* eb = F.a->in[I_MEB] + layer * 32;
    const GAS f32x4* gtab = (const GAS f32x4*)(F.ws + WS_CONST + 65536) + (size_t)layer * 9216 + lane; const GAS f32x4* etab = gtab + 1024;
    Route* route = (Route*)(F.ws + WS_ROUTE);
    LAS f32x4* etl = (LAS f32x4*)(F.lds + RING_OFF);
    f32x4 vfirst[4]; if (gw < M) load_row16(F.out + (size_t)gw * D, lane, vfirst);
    { const GAS f32x4* src = etab - lane;
#pragma unroll
      for (int i = 0; i < 16; ++i) etl[F.tid + 512 * i] = src[F.tid + 512 * i]; }
    LAS int* lcnt = (LAS int*)(F.lds + LDSCTL_OFF + 1280); LAS int* lbase = (LAS int*)(F.lds + LDSCTL_OFF + 1408);
    if (F.tid < 32) lcnt[F.tid] = 0;
    const bool agg = (M + NGW - 1) / NGW <= 64;
    f32x4 gt[16], gg[4];
#pragma unroll
    for (int i = 0; i < 16; ++i) gt[i] = gtab[i * 64];
    { const GAS f32x4* gr = (const GAS f32x4*)(F.a->in[I_FFNN] + layer * D) + lane;
#pragma unroll
      for (int j = 0; j < 4; ++j) gg[j] = gr[64 * j]; }
    __syncthreads();
    for (int dbgrep = ((layer == 0 ? 5 : 14) == DBG_REPEAT_PHASE ? 0 : 1); dbgrep < 2; ++dbgrep) {
    int myE0 = 0, myE1 = 0, myM = -1; float myW0 = 0.f, myW1 = 0.f; int jrow = 0;
    f32x4 v[4], vn[4];
#pragma unroll
    for (int j = 0; j < 4; ++j) vn[j] = vfirst[j];
    for (int m = gw; m < M; m += NGW, ++jrow) {
#pragma unroll
        for (int j = 0; j < 4; ++j) v[j] = vn[j];
        if (m + NGW < M) load_row16(F.out + (size_t)(m + NGW) * D, lane, vn);
        const float rinv = row_rinv(v);
        row_norm_store_g(v, rinv, gg, (bf16*)(F.ws + WS_XN) + (size_t)m * D, lane);
        float g0 = 0.f, g1 = 0.f, g2 = 0.f, g3 = 0.f;
#pragma unroll
        for (int j = 0; j < 4; ++j) {
#pragma unroll
            for (int c = 0; c < 4; ++c) { const f32x4 w = gt[4 * j + c]; const float hv = v[j][c]; g0 += hv * w.x; g1 += hv * w.y; g2 += hv * w.z; g3 += hv * w.w; } }
        g0 = wave_sum(g0) + gb[0]; g1 = wave_sum(g1) + gb[1]; g2 = wave_sum(g2) + gb[2]; g3 = wave_sum(g3) + gb[3];
        int gi = 0; float gm = g0; if (g1 > gm) { gm = g1; gi = 1; } if (g2 > gm) { gm = g2; gi = 2; } if (g3 > gm) { gm = g3; gi = 3; }
        const float pgrp = 1.0f / (expf(g0 - gm) + expf(g1 - gm) + expf(g2 - gm) + expf(g3 - gm));
        gi = __builtin_amdgcn_readfirstlane(gi);
        float e[8];
#pragma unroll
        for (int k = 0; k < 8; ++k) e[k] = 0.f;
        const LAS f32x4* ew = etl + gi * 2048 + lane;
#pragma unroll
        for (int j = 0; j < 4; ++j) {
#pragma unroll
            for (int c = 0; c < 4; ++c) { const f32x4 wa = ew[((4 * j + c) * 2) * 64], wb = ew[((4 * j + c) * 2 + 1) * 64]; const float hv = v[j][c];
                e[0] += hv * wa.x; e[1] += hv * wa.y; e[2] += hv * wa.z; e[3] += hv * wa.w; e[4] += hv * wb.x; e[5] += hv * wb.y; e[6] += hv * wb.z; e[7] += hv * wb.w; } }
#pragma unroll
        for (int k = 0; k < 8; ++k) e[k] = wave_sum(e[k]) + eb[gi * 8 + k];
        int i0 = 0; float m0 = e[0];
#pragma unroll
        for (int k = 1; k < 8; ++k) if (e[k] > m0) { m0 = e[k]; i0 = k; }
        int i1 = -1; float m1 = -INFINITY;
#pragma unroll
        for (int k = 0; k < 8; ++k) if (k != i0 && e[k] > m1) { m1 = e[k]; i1 = k; }
        const float t = expf(m1 - m0); const float w0 = pgrp / (1.0f + t), w1 = pgrp * t / (1.0f + t);
        if (lane == (jrow & 63)) { myE0 = gi * 8 + i0; myE1 = gi * 8 + i1; myW0 = w0; myW1 = w1; myM = m; }
#define ROUTE_EMIT(p0_, p1_) do { Route r; r.e0 = myE0; r.e1 = myE1; r.pos0 = (p0_); r.pos1 = (p1_); r.w0 = myW0; r.w1 = myW1; r.pad0 = 0; r.pad1 = 0; route[myM] = r; \
            int* list = (int*)(F.ws + WS_LIST); float* listw = (float*)(F.ws + WS_LIST + 2 * MiB); \
            list[(size_t)myE0 * M + (p0_)] = myM; listw[(size_t)myE0 * M + (p0_)] = myW0; list[(size_t)myE1 * M + (p1_)] = myM; listw[(size_t)myE1 * M + (p1_)] = myW1; } while (0)
        if (!agg && ((jrow & 63) == 63 || m + NGW >= M)) {
            if (myM >= 0 && dbgrep == 1) {
                const int p0 = (int)__hip_atomic_fetch_add(F.ctl + CW_CNT + (layer * 32 + myE0) * 64, 1u, RLX_AGENT);
                const int p1 = (int)__hip_atomic_fetch_add(F.ctl + CW_CNT + (layer * 32 + myE1) * 64, 1u, RLX_AGENT);
                ROUTE_EMIT(p0, p1);
            }
            myM = -1;
        }
    }
    if (agg) {
        const bool live = myM >= 0 && dbgrep == 1; int r0 = 0, r1 = 0;
        if (live) { r0 = __hip_atomic_fetch_add(lcnt + myE0, 1, __ATOMIC_RELAXED, __HIP_MEMORY_SCOPE_WORKGROUP); r1 = __hip_atomic_fetch_add(lcnt + myE1, 1, __ATOMIC_RELAXED, __HIP_MEMORY_SCOPE_WORKGROUP); }
        __syncthreads();
        if (F.tid < 32) { const int c = lcnt[F.tid]; lbase[F.tid] = c > 0 ? (int)__hip_atomic_fetch_add(F.ctl + CW_CNT + (layer * 32 + F.tid) * 64, (unsigned)c, RLX_AGENT) : 0; }
        __syncthreads();
        if (live) { const int p0 = lbase[myE0] + r0, p1 = lbase[myE1] + r1; ROUTE_EMIT(p0, p1); }
        if (F.tid < 32) lcnt[F.tid] = 0;
        __syncthreads();
    }
#undef ROUTE_EMIT
    }
}
DI void build_tables(Frame& F, int layer) {
    LAS int* tstart = (LAS int*)(F.lds + LDSCTL_OFF + 1024); LAS int* tmp = (LAS int*)(F.lds + LDSCTL_OFF + 1280); LAS int* tab = (LAS int*)(F.lds + LDSCTL_OFF + 2048);
    __syncthreads();
    if (F.tid < 32) { const int cnt = (int)__hip_atomic_load(F.ctl + CW_CNT + (layer * 32 + F.tid) * 64, RLX_AGENT); tmp[F.tid] = (cnt + 255) >> 8; ((LAS int*)(F.lds + LDSCTL_OFF + 1408))[F.tid] = cnt; }
    __syncthreads();
    if (F.tid < 32) { const int e = F.tid; int acc = 0;
#pragma unroll
        for (int k = 0; k < 32; ++k) { const int t = tmp[k]; acc += k < e ? t : 0; }
        tstart[e] = acc; const int n = tmp[e]; for (int t = 0; t < n; ++t) tab[1 + acc + t] = e; if (e == 31) { tstart[32] = acc + n; tab[0] = acc + n; } }
    __syncthreads();
}
template <class Sched> DI void moe_rowtab(Frame& F, const Sched& S, LAS int* rowtab, LAS float* wtab) {
    const LAS int* tstart = (const LAS int*)(F.lds + LDSCTL_OFF + 1024); const LAS int* cnts = (const LAS int*)(F.lds + LDSCTL_OFF + 1408); const LAS int* tab = (const LAS int*)(F.lds + LDSCTL_OFF + 2048);
    const int* list = (const int*)(F.ws + WS_LIST); const float* listw = (const float*)(F.ws + WS_LIST + 2 * MiB);
    const int i = F.tid >> 8, r = F.tid & 255; pg8::Unit u;
    if (S.next(i, u)) { const int e = tab[1 + u.pm], local = (u.pm - tstart[e]) * 256 + r; const bool ok = local < cnts[e];
        int tok = 0; float w = 0.f;
        if (ok) { tok = (int)__hip_atomic_load((const gu32*)list + (size_t)e * M + local, RLX_AGENT); w = __builtin_bit_cast(float, __hip_atomic_load((const gu32*)listw + (size_t)e * M + local, RLX_AGENT)); }
        rowtab[i * 256 + r] = tok; wtab[i * 256 + r] = w; }
    __syncthreads();
}
DI void p_combine(Frame& F, int layer, bool fin, bool tables_ready) {
    if (!tables_ready) build_tables(F, layer);
    const int gw = F.vcu * NWAVES + F.wave, NGW = F.G * NWAVES, lane = F.lane;
    const LAS int* tstart = (const LAS int*)(F.lds + LDSCTL_OFF + 1024); const Route* route = (const Route*)(F.ws + WS_ROUTE);
    const bf16* Y = (const bf16*)(F.ws + WS_XG);
    f32x4 gg[4]; { const GAS f32x4* gr = (const GAS f32x4*)(F.a->in[I_MIXN] + D) + lane;
#pragma unroll
        for (int j = 0; j < 4; ++j) gg[j] = fin ? f32x4{0.f, 0.f, 0.f, 0.f} : gr[64 * j]; }
    for (int dbgrep = ((layer == 0 ? 9 : 18) == DBG_REPEAT_PHASE ? 0 : 1); dbgrep < 2; ++dbgrep)
    for (int mb = gw; mb < M; mb += 64 * NGW) {
        int s0v = 0, s1v = 0;
        { const int mj = mb + NGW * lane;
          if (mj < M) { const gu32* rp = (const gu32*)(route + mj);
              const int e0 = (int)__hip_atomic_load(rp + 0, RLX_AGENT), e1 = (int)__hip_atomic_load(rp + 1, RLX_AGENT), q0 = (int)__hip_atomic_load(rp + 2, RLX_AGENT), q1 = (int)__hip_atomic_load(rp + 3, RLX_AGENT);
              s0v = 256 * tstart[e0] + q0; s1v = 256 * tstart[e1] + q1; } }
        f32x4 v[4], vn[4]; unsigned long long ya[4], yb[4], yan[4], ybn[4];
#define COMB_LOAD(m_, j_, X_, A_, B_) do { load_row16(F.out + (size_t)(m_) * D, lane, X_); \
            const int s0_ = __builtin_amdgcn_readlane(s0v, (j_)), s1_ = __builtin_amdgcn_readlane(s1v, (j_)); \
            const GAS unsigned long long* y0_ = (const GAS unsigned long long*)(Y + (size_t)s0_ * D) + lane; const GAS unsigned long long* y1_ = (const GAS unsigned long long*)(Y + (size_t)s1_ * D) + lane; \
            _Pragma("unroll") for (int q_ = 0; q_ < 4; ++q_) { A_[q_] = y0_[64 * q_]; B_[q_] = y1_[64 * q_]; } } while (0)
        COMB_LOAD(mb, 0, vn, yan, ybn);
        int j = 0;
        for (int m = mb; m < M && j < 64; m += NGW, ++j) {
#pragma unroll
            for (int q = 0; q < 4; ++q) { v[q] = vn[q]; ya[q] = yan[q]; yb[q] = ybn[q]; }
            if (m + NGW < M && j + 1 < 64) COMB_LOAD(m + NGW, j + 1, vn, yan, ybn);
            GAS f32x4* xo = (GAS f32x4*)(F.out + (size_t)m * D) + lane;
#pragma unroll
            for (int q = 0; q < 4; ++q) { const unsigned long long a = ya[q], b2 = yb[q];
                f32x4 add; add.x = bf2f((unsigned short)a) + bf2f((unsigned short)b2); add.y = bf2f((unsigned short)(a >> 16)) + bf2f((unsigned short)(b2 >> 16));
                add.z = bf2f((unsigned short)(a >> 32)) + bf2f((unsigned short)(b2 >> 32)); add.w = bf2f((unsigned short)(a >> 48)) + bf2f((unsigned short)(b2 >> 48));
                v[q] = v[q] + add; if (dbgrep == 1) xo[64 * q] = v[q]; }
            if (!fin && dbgrep == 1) { const float rinv = row_rinv(v); row_norm_store_g(v, rinv, gg, (bf16*)(F.ws + WS_XN) + (size_t)m * D, lane); }
        }
#undef COMB_LOAD
    }
}

__global__ void __launch_bounds__(NWAVES * 64, 2) hyb_fwd(Args args) {
    extern __shared__ __attribute__((aligned(16))) unsigned char lds[];
    Frame F;
    F.lds = (LAS unsigned char*)lds;
    F.MISC = (volatile LAS unsigned*)(F.lds + MISC_OFF);
    F.tid = threadIdx.x; F.lane = F.tid & 63; F.wave = __builtin_amdgcn_readfirstlane(F.tid >> 6);
    const int wave0 = F.wave;
    F.G = gridDim.x; { const int bx = blockIdx.x; F.vcu = (F.G % 8 == 0) ? (bx % 8) * (F.G / 8) + bx / 8 : bx; }
    F.a = (KArgs)__builtin_amdgcn_kernarg_segment_ptr(); F.ws = args.ws; F.ctl = (gu32*)(args.ws + WS_CTL); F.out = args.out;
    for (int u = F.tid; u < (LDS_BYTES - LDSCTL_OFF) / 4; u += NWAVES * 64) ((LAS unsigned*)(F.lds + LDSCTL_OFF))[u] = 0u;
    __syncthreads();
    const int lo = args.ph_lo, hi = args.ph_hi;
    XcdBarrier bar; bar.bar = (unsigned*)(F.ctl + CW_BAR); bar.x = 0; bar.st = nullptr; bar.tid = 0;
    if (hi - lo > 1) bar = xcd_barrier_post((unsigned*)(F.ctl + CW_BAR), F.MISC + 8);
#ifndef PH_EN
#define PH_EN 0x7ffff
#endif
#define IN(k) (((PH_EN >> (k)) & 1) && lo <= (k) && (k) < hi)
#ifndef DBG_REPEAT_PHASE
#define DBG_REPEAT_PHASE (-1)
#endif
#define REP(k) for (int rep_ = 0; rep_ < ((k) == DBG_REPEAT_PHASE ? 2 : 1); ++rep_)
#define SEAM(k) do { if (IN(k) && IN((k) + 1)) { XcdBarrier b2_ = bar; b2_.tid = F.tid; asm volatile("" : "+s"(b2_.bar)); xcd_barrier(b2_); if (DBG_REPEAT_PHASE == 99) xcd_barrier(b2_); } } while (0)
    bf16* XN = (bf16*)(F.ws + WS_XN);
#define PB() do { int t_ = wave0 * 64 + (int)__lane_id(); asm volatile("" : "+v"(t_)); F.tid = t_; F.lane = t_ & 63; F.wave = __builtin_amdgcn_readfirstlane(t_ >> 6); \
        KArgs a_ = (KArgs)__builtin_amdgcn_kernarg_segment_ptr(); asm volatile("" : "+s"(a_)); F.a = a_; F.ws = a_->ws; F.ctl = (gu32*)(a_->ws + WS_CTL); F.out = a_->out; XN = (bf16*)(F.ws + WS_XN); } while (0)

    if (IN(0)) { PB(); REP(0) p_prologue(F); SEAM(0); }
    if (IN(1)) { PB();
        pg8::Gemm g{XN, (const bf16*)(F.ws + WS_WABIN), M, AB_PROJ, D}; pg8::StaticOrder S; S.init(M, AB_PROJ, F.G, (int)blockIdx.x);
        pg8::EpiQKV0 E{F.ws, F.a->in[I_AQN], F.a->in[I_AKN], F.a->in[I_BQN], F.a->in[I_BKN], nullptr, C2, RMS_EPS};
        REP(1) pg8::gemm_phase<pg8::EpiQKV0, pg8::StaticOrder, PG8_ALIGN, PG8_SP2>(F.lds + RING_OFF, g, S, E, F.tid);
        SEAM(1);
    }
    if (IN(3)) { PB(); REP(3) p_attn_l0(F); SEAM(3); }
    if (IN(4)) { PB();
        pg8::Gemm g{(const bf16*)(F.ws + WS_O0), (const bf16*)(F.ws + WS_WABOUT), M, D, D}; pg8::StaticOrder S; S.init(M, D, F.G, (int)blockIdx.x);
        pg8::EpiResid E{F.a->in[I_X], F.out, D};
        REP(4) pg8::gemm_phase<pg8::EpiResid, pg8::StaticOrder, PG8_ALIGN, PG8_SP2>(F.lds + RING_OFF, g, S, E, F.tid);
        SEAM(4);
    }
#define MOE_BLOCK(layer, pb) do { \
        if (IN(pb)) { PB(); p_route(F, layer); SEAM(pb); } \
        if (IN((pb) + 2)) { PB(); \
            build_tables(F, layer); const LAS int* tab = (const LAS int*)(F.lds + LDSCTL_OFF + 2048); \
            const int T_ = __builtin_amdgcn_readfirstlane(tab[0]); \
            unsigned* ready = (unsigned*)(F.ctl + CW_RDY) + (size_t)(layer) * 160 * 64; \
            const int a_ = (2 * T_ > F.G && T_ <= F.G) ? 2 * T_ - F.G : 0;     \
            {     \
                pg8::Gemm g{XN, (const bf16*)(F.ws + WS_WGU) + (size_t)(layer) * (32 * 512 * 1024), M, 32 * 512, D}; \
                pg8::MoeOrderA S{tab, T_, a_, F.vcu}; \
                LAS int* rowtab = (LAS int*)(F.lds + LDSCTL_OFF + 4096); LAS float* wtab = (LAS float*)(F.lds + LDSCTL_OFF + 4096 + 2048); \
                moe_rowtab(F, S, rowtab, wtab); \
                pg8::EpiSwiGLU E{(bf16*)(F.ws + WS_A2), wtab}; \
                pg8::gemm_phase<pg8::EpiSwiGLU, pg8::MoeOrderA, PG8_ALIGN, PG8_SP2, true>(F.lds + RING_OFF, g, S, E, F.tid, rowtab); \
                  \
                asm volatile("s_waitcnt vmcnt(0)" ::: "memory"); __syncthreads(); \
                if (F.tid == 0) {     \
                    pg8::Unit u_; for (int i_ = 0; S.next(i_, u_); ++i_) __hip_atomic_fetch_add(ready + 64 * u_.pm, 1u, RLX_AGENT); } \
            } \
            PB(); \
            {     \
                const LAS int* tab = (const LAS int*)(F.lds + LDSCTL_OFF + 2048); unsigned* ready = (unsigned*)(F.ctl + CW_RDY) + (size_t)(layer) * 160 * 64; \
                pg8::Gemm g{(const bf16*)(F.ws + WS_A2), (const bf16*)(F.ws + WS_WD) + (size_t)(layer) * (32 * 1024 * 256), SLOT_CAP, 32 * 1024, DFF}; \
                const int c_ = F.vcu, early_ = 4 * (T_ - a_), late_ = 4 * a_, Lw_ = F.G - a_, li_ = c_ - a_; \
                const int ne_ = __builtin_amdgcn_readfirstlane((c_ >= a_ && li_ < early_) ? (early_ - li_ + Lw_ - 1) / Lw_ : 0);     \
                pg8::MoeOrder2 S{tab, __builtin_amdgcn_readfirstlane(early_), __builtin_amdgcn_readfirstlane(li_), __builtin_amdgcn_readfirstlane(Lw_), ne_, __builtin_amdgcn_readfirstlane(c_ < late_ ? early_ + c_ : -1), wave0, ready}; \
                pg8::EpiBf16Dst<pg8::ResY> E{pg8::ResY{(bf16*)(F.ws + WS_XG)}}; \
                pg8::gemm_phase<pg8::EpiBf16Dst<pg8::ResY>, pg8::MoeOrder2, false, PG8_SP2>(F.lds + RING_OFF, g, S, E, F.tid); \
            } \
            SEAM((pb) + 3); } \
        if (IN((pb) + 4)) { PB(); p_combine(F, layer, (layer) == 1, IN((pb) + 2)); SEAM((pb) + 4); } } while (0)
    MOE_BLOCK(0, 5);
    if (IN(10)) { PB();
        pg8::Gemm g{XN, (const bf16*)(F.ws + WS_WCIN), M, C_PROJ, D}; pg8::StaticOrder S; S.init(M, C_PROJ, F.G, (int)blockIdx.x);
        pg8::EpiQKV1 E{F.ws, F.a->in[I_CQN], F.a->in[I_CKN], nullptr, nullptr, (const float*)(F.ws + WS_CONST) + 1024, C2, RMS_EPS};
        REP(10) pg8::gemm_phase<pg8::EpiQKV1, pg8::StaticOrder, PG8_ALIGN, PG8_SP2>(F.lds + RING_OFF, g, S, E, F.tid);
        SEAM(10);
    }
    if (IN(12)) { PB();
        {
            const attn_body::AttnTensors AT{(const attn_body::bf16*)(F.ws + WS_Q1), (const attn_body::bf16*)(F.ws + WS_K1), (const attn_body::bf16*)(F.ws + WS_V1), (attn_body::bf16*)(F.ws + WS_O1), ((const float*)(F.ws + WS_CONST))[9]};
            const attn_body::StaticOrder S((int)F.G, (int)blockIdx.x);
            REP(12) { attn_body::AttnUnit u;
                LAS float* scr_ = (LAS float*)(F.lds + RING_OFF + 86016 + F.wave * WH_SCR_BYTES);
                DenseWStream hk{&F, __builtin_amdgcn_readfirstlane(F.vcu * NWAVES + F.wave), F.G * NWAVES, 0, 0, scr_, (unsigned)__builtin_amdgcn_readfirstlane((int)(unsigned)(uintptr_t)scr_)};
                for (int i = 0; S.next(i, u); ++i) { int t_ = F.tid; asm volatile("" : "+v"(t_));
                    attn_body::attn_unit<8, DenseWStream>(u.bh / attn_body::NHEAD, u.bh % attn_body::NHEAD, u.qb, AT.Q, AT.K, AT.V, AT.O, (char*)lds + RING_OFF, t_, AT.Mref, hk); }
                for (; hk.j < WSUB_L; hk.j += hk.stride) { const WHalf wd = moe_weight_half(F, wsub_of_layer(1, hk.j)); wh_issue(wd, F.lane, hk.scr_lds); asm volatile("s_waitcnt vmcnt(0)" ::: "memory"); wh_finish(wd, F.lane, scr_); }
            }
        }
        SEAM(12); }
    if (IN(13)) { PB();
        pg8::Gemm g{(const bf16*)(F.ws + WS_O1), (const bf16*)(F.ws + WS_WCOUT), M, D, D}; pg8::StaticOrder S; S.init(M, D, F.G, (int)blockIdx.x);
        pg8::EpiResid E{F.out, F.out, D};
        pg8::gemm_phase<pg8::EpiResid, pg8::StaticOrder, PG8_ALIGN, PG8_SP2>(F.lds + RING_OFF, g, S, E, F.tid);
        SEAM(13);
    }
    MOE_BLOCK(1, 14);
#undef IN
#undef SEAM
}

extern "C" void kernel_launch(void* const* d_in, const int* in_sizes, int n_in, void* d_out, int out_size, void* d_ws, size_t ws_size, hipStream_t stream) {
    static int grid = 0;
    if (grid == 0) {
        if (n_in != 21 || in_sizes[0] != M * D || out_size != M * D || ws_size < WS_END) { fprintf(stderr, "kernel_launch: unexpected shapes (n_in %d, in0 %d, out %d, ws %zu; need ws >= %zu); nothing launched\n", n_in, n_in > 0 ? in_sizes[0] : -1, out_size, ws_size, (size_t)WS_END); grid = -1; return; }
        int dev = 0, cus = 0, per_cu = 0;
        if (hipGetDevice(&dev) != hipSuccess || hipDeviceGetAttribute(&cus, hipDeviceAttributeMultiprocessorCount, dev) != hipSuccess) { grid = -1; return; }
        if (hipFuncSetAttribute((const void*)hyb_fwd, hipFuncAttributeMaxDynamicSharedMemorySize, LDS_BYTES) != hipSuccess) { fprintf(stderr, "kernel_launch: hipFuncSetAttribute failed\n"); grid = -1; return; }
        if (hipOccupancyMaxActiveBlocksPerMultiprocessor(&per_cu, (const void*)hyb_fwd, NWAVES * 64, LDS_BYTES) != hipSuccess || per_cu < 1) { fprintf(stderr, "kernel_launch: occupancy query reports %d workgroups per CU\n", per_cu); (void)hipGetLastError(); grid = -1; return; }
        grid = cus;
    }
    if (grid < 0) return;
    (void)hipMemsetAsync((char*)d_ws + WS_CTL, 0, CTL_ZERO_BYTES, stream);
    Args a{};
    for (int i = 0; i < 21; ++i) a.in[i] = (const float*)d_in[i];
    a.out = (float*)d_out; a.ws = (unsigned char*)d_ws;
#if MK_N_LAUNCHES == 1
    a.ph_lo = 0; a.ph_hi = NPHASE;
    hipLaunchKernelGGL(hyb_fwd, dim3(grid), dim3(NWAVES * 64), LDS_BYTES, stream, a);
#else
#ifndef DBG_LAST_PHASE
#define DBG_LAST_PHASE (NPHASE - 1)
#endif
    if (DBG_LAST_PHASE < 4) (void)hipMemcpyAsync(d_out, d_in[0], (size_t)M * D * 4, hipMemcpyDeviceToDevice, stream);
    for (int p = 0; p <= DBG_LAST_PHASE; ++p) { a.ph_lo = p; a.ph_hi = p + 1; hipLaunchKernelGGL(hyb_fwd, dim3(grid), dim3(NWAVES * 64), LDS_BYTES, stream, a); }
#endif
}
```

```cpp
#include <hip/hip_runtime.h>
#include <hip/hip_bf16.h>
#include <cstdio>
#include <cstdint>
#include <cmath>
#define MK_N_LAUNCHES 1
#define WCONV_IN_ATTN 1
namespace pg8 {
#define PG8_LAS __attribute__((address_space(3)))
typedef unsigned short bf16_t;
typedef short bf16x8 __attribute__((ext_vector_type(8)));
typedef float f32x4 __attribute__((ext_vector_type(4)));
typedef unsigned u32x4 __attribute__((ext_vector_type(4)));
constexpr int BM = 256, BK = 64, HALF = 128, HTB = HALF * BK * 2  , STAGE_BYTES = 8 * HTB, NXCD = 8, WGM = 8;

__host__ __device__ __forceinline__ int lds_byte(int r, int c) { const int st = (r >> 4) * 2 + (c >> 5), rr = r & 15, cc = c & 31, ob = rr * 64 + cc * 2; return st * 1024 + (ob ^ (((ob >> 9) & 1) << 5)); }
__host__ __device__ __forceinline__ void stage_rc(int b, int& R, int& C) { const int st = b / 1024, sb = b % 1024, swz = sb ^ (((sb >> 9) & 1) << 5); R = (st >> 1) * 16 + swz / 64; C = (st & 1) * 32 + (swz % 64) / 2; }
__host__ __device__ __forceinline__ int perm32(int rho) { const int n = rho >> 4, i = rho & 15; return 8 * (i >> 2) + 4 * n + (i & 3); }

struct Unit { int pm, pn, ord; };
struct Gemm { const bf16_t* A; const bf16_t* Bt; int M, N, K; };

struct StaticOrder {
    int nM, nN, nwg, G, c;
    __host__ __device__ void init(int M, int N, int G_, int c_) { nM = M / BM; nN = N / BM; nwg = nM * nN; G = G_; c = c_; }
    __host__ __device__ bool next(int i, Unit& u) const {
        const long L = (long)i * G + c; if (L >= nwg) return false;
        int wgid = (int)L; { const int q = nwg / NXCD, r = nwg % NXCD, xcd = wgid % NXCD, off = wgid / NXCD; wgid = (xcd < r ? xcd * (q + 1) : r * (q + 1) + (xcd - r) * q) + off; }
        const int nig = WGM * nN, gid = wgid / nig, fm = gid * WGM, gsz = (nM - fm) < WGM ? (nM - fm) : WGM;
        u.pm = fm + ((wgid % nig) % gsz); u.pn = (wgid % nig) / gsz; return true;
    }
    __device__ __forceinline__ void a_ready(const Unit&) const {}
    __device__ __forceinline__ void done(const Unit&) const {}
};

__device__ __forceinline__ unsigned cvt_pk_bf16(float lo, float hi) { unsigned r; asm volatile("v_cvt_pk_bf16_f32 %0, %1, %2" : "=v"(r) : "v"(lo), "v"(hi)); return r; }
typedef float f32x2 __attribute__((ext_vector_type(2)));
struct DstTile { bf16_t* p; int ldc; int c0; };
struct ResY { bf16_t* y;
    __device__ __forceinline__ DstTile operator()(int pn) const { return DstTile{y, 1024, 256 * (pn & 3)}; } };

template <class R> struct EpiBf16Dst {
    static constexpr bool PERM = true, AFTER_DRAIN = false;
    R res;
    __device__ __forceinline__ void operator()(const f32x4 (&acc)[2][2][4][2], const Unit& u, int wr, int wc, int fr, int fq) const {
        asm volatile("" : "+v"(fr), "+v"(fq));
        const DstTile d = res(u.pn);
        const int row0 = u.pm * BM + wr * 64 + fr; const int col0 = d.c0 + wc * 32 + 8 * fq;
#pragma unroll
        for (int ai = 0; ai < 2; ++ai)
#pragma unroll
            for (int m = 0; m < 4; ++m) { bf16_t* rowp = d.p + (size_t)(row0 + ai * HALF + m * 16) * d.ldc + col0;
#pragma unroll
                for (int bj = 0; bj < 2; ++bj) { const f32x4 v0 = acc[ai][bj][m][0], v1 = acc[ai][bj][m][1];
                    u32x4 w; w.x = cvt_pk_bf16(v0[0], v0[1]); w.y = cvt_pk_bf16(v0[2], v0[3]); w.z = cvt_pk_bf16(v1[0], v1[1]); w.w = cvt_pk_bf16(v1[2], v1[3]);
                    *(u32x4*)(rowp + bj * HALF) = w; } }
    }
};
struct EpiResid {
    static constexpr bool PERM = false, AFTER_DRAIN = false;
    const float* base; float* out; int ldc;
    __device__ __forceinline__ void operator()(const f32x4 (&acc)[2][2][4][2], const Unit& u, int wr, int wc, int fr, int fq) const {
        asm volatile("" : "+v"(fr), "+v"(fq));
        const int col0 = u.pn * BM + wc * 32 + 4 * fq;
#pragma unroll
        for (int ai = 0; ai < 2; ++ai)
#pragma unroll
            for (int m = 0; m < 4; ++m) { const size_t off = (size_t)(u.pm * BM + ai * HALF + wr * 64 + m * 16 + fr) * ldc + col0;
#pragma unroll
                for (int bj = 0; bj < 2; ++bj)
#pragma unroll
                    for (int n = 0; n < 2; ++n) { const f32x4 b = *(const f32x4*)(base + off + bj * HALF + n * 16); *(f32x4*)(out + off + bj * HALF + n * 16) = b + acc[ai][bj][m][n]; }
                asm volatile("" ::: "memory"); }
    }
};
__device__ __forceinline__ float silu_f(float a) { return a * __builtin_amdgcn_rcpf(1.0f + __builtin_amdgcn_exp2f(-1.4426950408889634f * a)); }
struct EpiSwiGLU {
    static constexpr bool PERM = true, AFTER_DRAIN = false;
    bf16_t* A2; const PG8_LAS float* wtab;
    __device__ __forceinline__ void operator()(const f32x4 (&acc)[2][2][4][2], const Unit& u, int wr, int wc, int fr, int fq) const {
        asm volatile("" : "+v"(fr), "+v"(fq));
        const int j = u.pn & 1; const int row0 = u.pm * BM + wr * 64 + fr; const int col0 = j * 128 + wc * 32 + 8 * fq;
#pragma unroll
        for (int ai = 0; ai < 2; ++ai)
#pragma unroll
            for (int m = 0; m < 4; ++m) { const int row = row0 + ai * HALF + m * 16; const float w = wtab[u.ord * 256 + ai * HALF + wr * 64 + m * 16 + fr];
                const f32x4 g0 = acc[ai][0][m][0], g1 = acc[ai][0][m][1], u0 = acc[ai][1][m][0], u1 = acc[ai][1][m][1];
                u32x4 o;
                o.x = cvt_pk_bf16(silu_f(g0[0]) * u0[0] * w, silu_f(g0[1]) * u0[1] * w); o.y = cvt_pk_bf16(silu_f(g0[2]) * u0[2] * w, silu_f(g0[3]) * u0[3] * w);
                o.z = cvt_pk_bf16(silu_f(g1[0]) * u1[0] * w, silu_f(g1[1]) * u1[1] * w); o.w = cvt_pk_bf16(silu_f(g1[2]) * u1[2] * w, silu_f(g1[3]) * u1[3] * w);
                bf16_t* dst_ = A2 + (size_t)row * 256 + col0;
                asm volatile("global_store_dwordx4 %0, %1, off sc1\n\ts_nop 1" :: "v"(dst_), "v"(o) : "memory"); }
    }
};
struct MoeOrderA {
    const PG8_LAS int* tab; int T, a, c;
    __device__ __forceinline__ bool next(int i, Unit& u) const {
        int tile, j;
        if (c < a) { if (i >= 2) return false; tile = T - a + c; j = i; }
        else { const int li = c - a; if (i >= 1 || li >= 2 * (T - a)) return false; tile = li >> 1; j = li & 1; }
        u.pm = tile; u.pn = __builtin_amdgcn_readfirstlane(tab[1 + tile]) * 2 + j; u.ord = i; return true;
    }
    __device__ __forceinline__ void a_ready(const Unit&) const {}
    __device__ __forceinline__ void done(const Unit&) const {}
};
struct MoeOrder2 {
    const PG8_LAS int* tab; int early, li, Lw, ne, qlate, wave; unsigned* ready;
    __device__ __forceinline__ bool next(int i, Unit& u) const {
        int q;
        if (i < ne) q = li + i * Lw; else if (i == ne && qlate >= 0) q = qlate; else return false;
        const int tile = q >> 2;
        u.pm = tile; u.pn = __builtin_amdgcn_readfirstlane(tab[1 + tile]) * 4 + (q & 3); u.ord = i; return true;
    }
    __device__ __forceinline__ void a_ready(const Unit& u) const {
        if (wave == 0) {
            for (unsigned sp = 0; sp < (1u << 21); ++sp) {
                if ((unsigned)__builtin_amdgcn_readfirstlane(__hip_atomic_load(ready + 64 * u.pm, __ATOMIC_RELAXED, __HIP_MEMORY_SCOPE_AGENT)) >= 2u) break;
                __builtin_amdgcn_s_sleep(2); }
            __builtin_amdgcn_fence(__ATOMIC_ACQUIRE, "agent");
            asm volatile("s_waitcnt vmcnt(0)" ::: "memory");
        }
        asm volatile("" ::: "memory"); __builtin_amdgcn_s_barrier(); asm volatile("" ::: "memory");
    }
    __device__ __forceinline__ void done(const Unit&) const {}
};
__device__ __forceinline__ int qkv_drow(int n0) { return (n0 & ~255) + 128 * ((n0 >> 5) & 1) + 32 * ((n0 >> 6) & 3); }
__device__ __forceinline__ float xor16_f(float v) { return __builtin_bit_cast(float, __builtin_amdgcn_ds_swizzle(__builtin_bit_cast(int, v), (16 << 10) | 0x1f)); }
__device__ __forceinline__ void halves_f(float v, float& lo, float& hi) { lo = v; hi = v; asm volatile("s_nop 1\n\tv_permlane32_swap_b32 %0, %1\n\ts_nop 1" : "+v"(lo), "+v"(hi)); }
template <int LAYER, unsigned OFF0, unsigned OFF1, unsigned OFF2, unsigned OFF3> struct EpiQKV {
    static constexpr bool PERM = true, AFTER_DRAIN = false;
    unsigned char* ws; const float* g0; const float* g1; const float* g2; const float* g3;
    const PG8_LAS float* rtab; float c2, eps;
    __device__ __forceinline__ void operator()(const f32x4 (&acc)[2][2][4][2], const Unit& u, int wr, int wc, int fr, int fq) const {
        asm volatile("" : "+v"(fr), "+v"(fq));
        const int pn = u.pn; const float* gain = nullptr; float scale = 1.0f; bool rope = false; unsigned off; int ldc, c0;
        if (LAYER == 0) {
            if (pn < 2) { gain = g0; scale = c2; off = OFF0; ldc = 1024; c0 = 256 * pn; }
            else if (pn < 4) { gain = g1; off = OFF1; ldc = 512; c0 = 256 * (pn - 2); }
            else if (pn < 6) { off = OFF2; ldc = 512; c0 = 256 * (pn - 4); }
            else if (pn < 8) { gain = g2; scale = c2; off = OFF0; ldc = 1024; c0 = 512 + 256 * (pn - 6); }
            else { if (wc < 2) gain = g3; off = OFF3; ldc = 256; c0 = 0; }
        } else {
            if (pn < 4) { gain = g0; scale = c2; rope = true; off = OFF0; ldc = 1024; c0 = 256 * pn; }
            else if (pn == 4) { gain = g1; rope = true; off = OFF1; ldc = 256; c0 = 0; }
            else { off = OFF2; ldc = 256; c0 = 0; }
        }
        bf16_t* base = (bf16_t*)(ws + off);
        const int col0 = c0 + 64 * wc + 8 * fq;
        f32x4 gv[2][2];
        if (gain) {
#pragma unroll
            for (int bj = 0; bj < 2; ++bj)
#pragma unroll
                for (int n = 0; n < 2; ++n) gv[bj][n] = *(const f32x4*)(gain + 32 * bj + 8 * fq + 4 * n);
        }
#pragma unroll
        for (int ai = 0; ai < 2; ++ai)
#pragma unroll
            for (int m = 0; m < 4; ++m) {
                const int row = u.pm * BM + ai * HALF + wr * 64 + m * 16 + fr;
                f32x4 v[2][2];
#pragma unroll
                for (int bj = 0; bj < 2; ++bj)
#pragma unroll
                    for (int n = 0; n < 2; ++n) v[bj][n] = acc[ai][bj][m][n];
                if (gain) {
                    float ss = 0.f;
#pragma unroll
                    for (int bj = 0; bj < 2; ++bj)
#pragma unroll
                        for (int n = 0; n < 2; ++n) ss += (v[bj][n][0] * v[bj][n][0] + v[bj][n][1] * v[bj][n][1]) + (v[bj][n][2] * v[bj][n][2] + v[bj][n][3] * v[bj][n][3]);
                    ss += xor16_f(ss); { float lo, hi; halves_f(ss, lo, hi); ss = lo + hi; }
                    const float rinv = 1.0f / sqrtf(ss * (1.0f / 64.0f) + eps);
#pragma unroll
                    for (int bj = 0; bj < 2; ++bj)
#pragma unroll
                        for (int n = 0; n < 2; ++n) v[bj][n] = v[bj][n] * rinv * gv[bj][n];
                    if (rope) {
                        const int pos = row & 8191;
#pragma unroll
                        for (int bj = 0; bj < 2; ++bj) {
                            const PG8_LAS float* t = rtab + (bj == 0 ? (pos >> 6) : 128 + (pos & 63)) * 32 + 8 * (fq & 1);
#pragma unroll
                            for (int n = 0; n < 2; ++n) { const f32x4 cs = *(const PG8_LAS f32x4*)(t + 4 * n), sn = *(const PG8_LAS f32x4*)(t + 16 + 4 * n);
#pragma unroll
                                for (int i = 0; i < 4; ++i) { float lo, hi; halves_f(v[bj][n][i], lo, hi); const float y = v[bj][n][i], yp = (fq >= 2) ? lo : hi;
                                    v[bj][n][i] = (fq >= 2) ? (y * cs[i] + yp * sn[i]) : (y * cs[i] - yp * sn[i]); } }
                        }
                    }
                }
                bf16_t* rowp = base + (size_t)row * ldc + col0;
#pragma unroll
                for (int bj = 0; bj < 2; ++bj) { const f32x4 a = v[bj][0] * scale, b = v[bj][1] * scale;
                    u32x4 w; w.x = cvt_pk_bf16(a[0], a[1]); w.y = cvt_pk_bf16(a[2], a[3]); w.z = cvt_pk_bf16(b[0], b[1]); w.w = cvt_pk_bf16(b[2], b[3]);
                    *(u32x4*)(rowp + 32 * bj) = w; }
            }
    }
};
template <class Epi, class Sched, bool ALIGN_EPI = false, bool SP2 = false, bool GATHER = false>
__device__ __forceinline__ void gemm_phase(PG8_LAS unsigned char* lds, const Gemm g, const Sched& S, const Epi& E, const int tid_in, const PG8_LAS int* rowtab = nullptr) {
    static_assert(!GATHER || SP2, "GATHER is written for the SP2 loop");
    int tid_ = tid_in; asm volatile("" : "+v"(tid_));
    const int tid = tid_, wid = __builtin_amdgcn_readfirstlane(tid >> 6), lane = tid & 63, wr = wid >> 2, wc = wid & 3, fr = lane & 15, fq = lane >> 4;
    const int K = g.K, nt = K / BK;
    unsigned voffA[2], voffB[2]; int Rg[2]; unsigned Cg2[2];
#pragma unroll
    for (int i = 0; i < 2; ++i) { int R, C; stage_rc(tid * 16 + i * 8192, R, C); const int Rb = Epi::PERM ? ((R & ~31) + perm32(R & 31)) : R;
        voffA[i] = (unsigned)(R * K + C) * 2u; voffB[i] = (unsigned)(Rb * K + C) * 2u; Rg[i] = R; Cg2[i] = (unsigned)C * 2u; }
    unsigned vc[2][2], vn[2][2];
#define PG8_ROWS(V, ord) do { _Pragma("unroll") for (int _h = 0; _h < 2; ++_h) _Pragma("unroll") for (int _i = 0; _i < 2; ++_i) V[_h][_i] = (unsigned)rowtab[(ord) * 256 + _h * HALF + Rg[_i]] * (unsigned)(K * 2) + Cg2[_i]; } while (0)
#define PG8_STAGE_G(bufoff, kb, V) do { _Pragma("unroll") for (int _i = 0; _i < 2; ++_i) \
        __builtin_amdgcn_global_load_lds((const unsigned*)((const char*)g.A + (kb) + (V)[_i]), (PG8_LAS unsigned*)(lds + (bufoff) + ldsw + _i * 8192), 16, 0, 0); } while (0)
    const size_t kstep = (size_t)(BK * 2);
    const size_t hstep = (size_t)HALF * K * 2;
    const size_t tstep = 2 * hstep;
    const unsigned ldsw = (unsigned)wid * 1024u;
    const int aoff = lds_byte(wr * 64 + fr, fq * 8), boff = lds_byte(wc * 32 + fr, fq * 8);
#define PG8_SA(b, h) (((b) * 2 + (h)) * HTB)
#define PG8_SB(b, h) ((4 + (b) * 2 + (h)) * HTB)
#define PG8_STAGE(bufoff, gbase, voff) do { _Pragma("unroll") for (int _i = 0; _i < 2; ++_i) \
        __builtin_amdgcn_global_load_lds((const unsigned*)((const char*)(gbase) + (voff)[_i]), (PG8_LAS unsigned*)(lds + (bufoff) + ldsw + _i * 8192), 16, 0, 0); } while (0)
#define PG8_LDA(dst, b, h) do { _Pragma("unroll") for (int m = 0; m < 4; ++m) _Pragma("unroll") for (int k = 0; k < 2; ++k) dst[m][k] = *(const PG8_LAS bf16x8*)(lds + PG8_SA(b, h) + aoff + m * 2048 + k * 1024); } while (0)
#define PG8_LDB(dst, b, h) do { _Pragma("unroll") for (int n = 0; n < 2; ++n) _Pragma("unroll") for (int k = 0; k < 2; ++k) dst[n][k] = *(const PG8_LAS bf16x8*)(lds + PG8_SB(b, h) + boff + n * 2048 + k * 1024); } while (0)
#define PG8_MMA(ai, bj, At, Bt) do { __builtin_amdgcn_s_setprio(1); _Pragma("unroll") for (int m = 0; m < 4; ++m) _Pragma("unroll") for (int n = 0; n < 2; ++n) _Pragma("unroll") for (int k = 0; k < 2; ++k) \
        acc[ai][bj][m][n] = __builtin_amdgcn_mfma_f32_16x16x32_bf16(Bt[n][k], At[m][k], acc[ai][bj][m][n], 0, 0, 0); __builtin_amdgcn_s_setprio(0); } while (0)
#define PG8_WAIT_V(n) asm volatile("s_waitcnt vmcnt(" #n ")" ::: "memory")
#define PG8_WAIT_L(n) asm volatile("s_waitcnt lgkmcnt(" #n ")" ::: "memory")
#define PG8_BAR __builtin_amdgcn_s_barrier()
#define PG8_SCHED __builtin_amdgcn_sched_barrier(0)
    Unit cur, nxt; int ui = 0;
    if (!S.next(0, cur)) return;
    f32x4 acc[2][2][4][2];
#pragma unroll
    for (int a = 0; a < 2; ++a)
#pragma unroll
        for (int b = 0; b < 2; ++b)
#pragma unroll
            for (int m = 0; m < 4; ++m)
#pragma unroll
                for (int n = 0; n < 2; ++n) acc[a][b][m][n] = (f32x4){0.f, 0.f, 0.f, 0.f};
    bf16x8 At[4][2], B0[2][2], B1[2][2];
    const char* cA = (const char*)g.A + (size_t)cur.pm * tstep; const char* cB = (const char*)g.Bt + (size_t)cur.pn * tstep;
    S.a_ready(cur);
    if constexpr (SP2) {
        if constexpr (GATHER) { PG8_ROWS(vc, 0); }
        PG8_STAGE(PG8_SB(0, 0), cB, voffB); PG8_STAGE(PG8_SB(0, 1), cB + hstep, voffB);
        if constexpr (GATHER) { PG8_STAGE_G(PG8_SA(0, 0), 0, vc[0]); PG8_STAGE_G(PG8_SA(0, 1), 0, vc[1]); } else { PG8_STAGE(PG8_SA(0, 0), cA, voffA); PG8_STAGE(PG8_SA(0, 1), cA + hstep, voffA); }
        if (wr == 1) PG8_BAR;
        PG8_WAIT_V(2); PG8_BAR;
        PG8_STAGE(PG8_SB(1, 0), cB + kstep, voffB); if constexpr (GATHER) { PG8_STAGE_G(PG8_SA(1, 0), kstep, vc[0]); } else { PG8_STAGE(PG8_SA(1, 0), cA + kstep, voffA); } PG8_STAGE(PG8_SB(1, 1), cB + hstep + kstep, voffB);
        PG8_WAIT_V(6); PG8_BAR;
    } else {
        PG8_STAGE(PG8_SB(0, 0), cB, voffB); PG8_STAGE(PG8_SA(0, 0), cA, voffA); PG8_STAGE(PG8_SB(0, 1), cB + hstep, voffB); PG8_STAGE(PG8_SA(0, 1), cA + hstep, voffA);
        if (wr == 1) PG8_BAR;
        PG8_WAIT_V(4); PG8_BAR;
        PG8_STAGE(PG8_SB(1, 0), cB + kstep, voffB); PG8_STAGE(PG8_SA(1, 0), cA + kstep, voffA); PG8_STAGE(PG8_SB(1, 1), cB + hstep + kstep, voffB);
        PG8_WAIT_V(6); PG8_BAR;
    }
    for (;;) {
        const bool has_next = S.next(ui + 1, nxt);
        const char* nA = has_next ? (const char*)g.A + (size_t)nxt.pm * tstep : cA; const char* nB = has_next ? (const char*)g.Bt + (size_t)nxt.pn * tstep : cB;
        if constexpr (GATHER) { if (has_next) { PG8_ROWS(vn, ui + 1); } else { _Pragma("unroll") for (int _h = 0; _h < 2; ++_h) _Pragma("unroll") for (int _i = 0; _i < 2; ++_i) vn[_h][_i] = vc[_h][_i]; } }
        for (int t = 0; t < nt; t += 2) {
            const bool last = (t == nt - 2);
            const char* a1 = cA + (size_t)(t + 1) * kstep;
            const char* a2 = last ? nA : cA + (size_t)(t + 2) * kstep; const char* b2 = last ? nB : cB + (size_t)(t + 2) * kstep;
            const char* a3 = a2 + kstep; const char* b3 = b2 + kstep;
            if (last && has_next) S.a_ready(nxt);
            if constexpr (SP2) {
            unsigned w0[2], w1[2]; size_t kb2 = 0;
            if constexpr (GATHER) { kb2 = last ? (size_t)0 : (size_t)(t + 2) * kstep; _Pragma("unroll") for (int _i = 0; _i < 2; ++_i) { w0[_i] = last ? vn[0][_i] : vc[0][_i]; w1[_i] = last ? vn[1][_i] : vc[1][_i]; } }
            PG8_LDB(B0, 0, 0); PG8_LDB(B1, 0, 1); PG8_SCHED; PG8_LDA(At, 0, 0); if constexpr (GATHER) { PG8_STAGE_G(PG8_SA(1, 1), (size_t)(t + 1) * kstep, vc[1]); } else { PG8_STAGE(PG8_SA(1, 1), a1 + hstep, voffA); }
            PG8_WAIT_V(8); PG8_WAIT_L(0); PG8_BAR; PG8_MMA(0, 0, At, B0); PG8_MMA(0, 1, At, B1); PG8_BAR; PG8_SCHED;
            PG8_LDA(At, 0, 1); PG8_STAGE(PG8_SB(0, 0), b2, voffB); PG8_STAGE(PG8_SB(0, 1), b2 + hstep, voffB); if constexpr (GATHER) { PG8_STAGE_G(PG8_SA(0, 0), kb2, w0); } else { PG8_STAGE(PG8_SA(0, 0), a2, voffA); }
            PG8_WAIT_V(8); PG8_WAIT_L(0); PG8_BAR; PG8_MMA(1, 0, At, B0); PG8_MMA(1, 1, At, B1); PG8_BAR; PG8_SCHED;
            PG8_LDB(B0, 1, 0); PG8_LDB(B1, 1, 1); PG8_SCHED; PG8_LDA(At, 1, 0); if constexpr (GATHER) { PG8_STAGE_G(PG8_SA(0, 1), kb2, w1); } else { PG8_STAGE(PG8_SA(0, 1), a2 + hstep, voffA); }
            PG8_WAIT_V(8); PG8_WAIT_L(0); PG8_BAR; PG8_MMA(0, 0, At, B0); PG8_MMA(0, 1, At, B1); PG8_BAR; PG8_SCHED;
            PG8_LDA(At, 1, 1); PG8_STAGE(PG8_SB(1, 0), b3, voffB); PG8_STAGE(PG8_SB(1, 1), b3 + hstep, voffB); if constexpr (GATHER) { PG8_STAGE_G(PG8_SA(1, 0), kb2 + kstep, w0); } else { PG8_STAGE(PG8_SA(1, 0), a3, voffA); }
            PG8_WAIT_V(8); PG8_WAIT_L(0); PG8_BAR; PG8_MMA(1, 0, At, B0); PG8_MMA(1, 1, At, B1); PG8_BAR; PG8_SCHED;
            } else {
            PG8_LDB(B0, 0, 0); PG8_SCHED; PG8_LDA(At, 0, 0); PG8_STAGE(PG8_SA(1, 1), a1 + hstep, voffA);
            PG8_WAIT_L(8); PG8_BAR; PG8_WAIT_L(0); PG8_MMA(0, 0, At, B0); PG8_BAR; PG8_SCHED;
            PG8_LDB(B1, 0, 1); PG8_STAGE(PG8_SB(0, 0), b2, voffB);
            PG8_BAR; PG8_WAIT_L(0); PG8_MMA(0, 1, At, B1); PG8_BAR;
            PG8_LDA(At, 0, 1); PG8_STAGE(PG8_SA(0, 0), a2, voffA);
            PG8_BAR; PG8_WAIT_L(0); PG8_MMA(1, 0, At, B0); PG8_BAR; PG8_SCHED;
            PG8_STAGE(PG8_SB(0, 1), b2 + hstep, voffB);
            PG8_WAIT_V(6); PG8_BAR; PG8_MMA(1, 1, At, B1); PG8_BAR;
            PG8_LDB(B0, 1, 0); PG8_SCHED; PG8_LDA(At, 1, 0); PG8_STAGE(PG8_SA(0, 1), a2 + hstep, voffA);
            PG8_WAIT_L(8); PG8_BAR; PG8_WAIT_L(0); PG8_MMA(0, 0, At, B0); PG8_BAR; PG8_SCHED;
            PG8_LDB(B1, 1, 1); PG8_STAGE(PG8_SB(1, 0), b3, voffB);
            PG8_BAR; PG8_WAIT_L(0); PG8_MMA(0, 1, At, B1); PG8_BAR;
            PG8_LDA(At, 1, 1); PG8_STAGE(PG8_SA(1, 0), a3, voffA);
            PG8_BAR; PG8_WAIT_L(0); PG8_MMA(1, 0, At, B0); PG8_BAR; PG8_SCHED;
            PG8_STAGE(PG8_SB(1, 1), b3 + hstep, voffB);
            PG8_WAIT_V(6); PG8_BAR; PG8_MMA(1, 1, At, B1); PG8_BAR;
            }
        }
        if constexpr (ALIGN_EPI) { if (wr == 0) PG8_BAR; }
        if constexpr (!Epi::AFTER_DRAIN) { int le_ = tid; asm volatile("" : "+v"(le_)); E(acc, cur, wr, wc, le_ & 15, (le_ >> 4) & 3); S.done(cur); }
        if (!has_next) break;
#pragma unroll
        for (int a = 0; a < 2; ++a)
#pragma unroll
            for (int b = 0; b < 2; ++b)
#pragma unroll
                for (int m = 0; m < 4; ++m)
#pragma unroll
                    for (int n = 0; n < 2; ++n) acc[a][b][m][n] = (f32x4){0.f, 0.f, 0.f, 0.f};
        cur = nxt; cA = nA; cB = nB; ++ui;
        if constexpr (GATHER) { _Pragma("unroll") for (int _h = 0; _h < 2; ++_h) _Pragma("unroll") for (int _i = 0; _i < 2; ++_i) vc[_h][_i] = vn[_h][_i]; }
        if constexpr (ALIGN_EPI) { if (wr == 1) PG8_BAR; }
    }
    PG8_WAIT_V(0);
    if constexpr (!ALIGN_EPI) { if (wr == 0) PG8_BAR; }
    PG8_BAR;
    if constexpr (Epi::AFTER_DRAIN) { E.fused(acc, cur, wr, wc, fr, fq, lds, wid, lane); S.done(cur); }
#undef PG8_ROWS
#undef PG8_STAGE_G
#undef PG8_SA
#undef PG8_SB
#undef PG8_STAGE
#undef PG8_LDA
#undef PG8_LDB
#undef PG8_MMA
#undef PG8_WAIT_V
#undef PG8_WAIT_L
#undef PG8_BAR
#undef PG8_SCHED
}
}

#ifndef DBG_REPEAT_PHASE
#define DBG_REPEAT_PHASE (-1)
#endif
#ifndef PG8_SP2
#define PG8_SP2 true
#endif
#ifndef PG8_ALIGN
#define PG8_ALIGN true
#endif
#ifndef MK_N_LAUNCHES
#define MK_N_LAUNCHES 1
#endif
constexpr int NWAVES = 8;
constexpr int BATCH = 2, SEQ = 8192, D = 1024, M = BATCH * SEQ;
constexpr int HD = 64;
constexpr int AB_PROJ = 2304, C_PROJ = 1536;
constexpr int NEXP = 32, DFF = 256;
constexpr int SLOT_CAP = 40960;
constexpr float RMS_EPS = 1e-6f;
constexpr float LOG2E = 1.4426950408889634f;
constexpr float C2 = 0.125f * LOG2E;
constexpr int NPHASE = 19;

constexpr size_t MiB = 1u << 20;
constexpr size_t WS_CTL = 0, CTL_ZERO_BYTES = 1 * MiB;
constexpr size_t WS_CONST = 1 * MiB;
constexpr size_t WS_WABIN = 2 * MiB, WS_WABOUT = 7 * MiB, WS_WCIN = 9 * MiB, WS_WCOUT = 12 * MiB;
constexpr size_t WS_WGU = 14 * MiB;
constexpr size_t WS_WD = 78 * MiB;
constexpr size_t WS_XN = 110 * MiB;
constexpr size_t WS_ROUTE = 142 * MiB;
constexpr size_t WS_P = 144 * MiB;
constexpr size_t WS_QAB = WS_P, WS_KA = WS_P + 32 * MiB, WS_VA = WS_P + 48 * MiB, WS_KVB = WS_P + 64 * MiB;
constexpr size_t WS_O0 = WS_P + 72 * MiB;
constexpr size_t WS_O1 = WS_P + 48 * MiB;
constexpr size_t WS_Q1 = WS_P, WS_K1 = WS_P + 32 * MiB, WS_V1 = WS_P + 40 * MiB;
constexpr size_t WS_XG = WS_P, WS_A2 = WS_P + 80 * MiB;
constexpr size_t WS_LIST = WS_P + 100 * MiB;
constexpr size_t WS_END = WS_LIST + 4 * MiB;
static_assert((size_t)SLOT_CAP * 1024 * 2 == 80 * MiB && (size_t)SLOT_CAP * 256 * 2 == 20 * MiB, "slot buffers");
constexpr int CW_TMO = 0;
constexpr int CW_BAR = 4096;
constexpr int CW_CNT = 16384;
constexpr int CW_RDY = 20480;

constexpr int RING_OFF = 0, RING_BYTES = 131072;
constexpr int LDSCTL_OFF = RING_BYTES, MISC_OFF = LDSCTL_OFF + 320;
constexpr int ROPE_LDS_OFF = LDSCTL_OFF + 8192;
constexpr int LDS_BYTES = 163840;
#define GAS __attribute__((address_space(1)))
#define LAS __attribute__((address_space(3)))
typedef unsigned short bf16;
typedef unsigned v4u __attribute__((ext_vector_type(4)));
typedef float f32x4 __attribute__((ext_vector_type(4)));
typedef short bf16x8 __attribute__((ext_vector_type(8)));
typedef GAS unsigned gu32;
typedef GAS unsigned long long gu64;
#define RLX_AGENT __ATOMIC_RELAXED, __HIP_MEMORY_SCOPE_AGENT
#define LDS_WAIT() asm volatile("s_waitcnt lgkmcnt(0)" ::: "memory")
#define VM_WAIT() asm volatile("s_waitcnt vmcnt(0)" ::: "memory")
__device__ __forceinline__ unsigned long long rt() { return __builtin_amdgcn_s_memrealtime(); }
__device__ __forceinline__ unsigned f2bf(float f) { unsigned u = __builtin_bit_cast(unsigned, f); return (u + 0x7fffu + ((u >> 16) & 1u)) >> 16; }
__device__ __forceinline__ unsigned pk2(float lo, float hi) { return f2bf(lo) | (f2bf(hi) << 16); }
#define XB_TMO      128
#define XB_XCNT(j)  (256  + 64 * (j))
#define XB_XSUB(j)  (1280 + 64 * (j))
#define XB_XGEN(j)  (2304 + 64 * (j))
#define XB_TOP      3328
#define XB_TOPGEN   3392
#define XCD_BAR_WORDS 3456
#define XB_SPIN_CAP (1u << 18)

__device__ __forceinline__ unsigned xb_ld(unsigned* p)              { return __hip_atomic_load(p, __ATOMIC_RELAXED, __HIP_MEMORY_SCOPE_AGENT); }
__device__ __forceinline__ unsigned xb_add(unsigned* p, unsigned v) { return __hip_atomic_fetch_add(p, v, __ATOMIC_RELAXED, __HIP_MEMORY_SCOPE_AGENT); }
__device__ __forceinline__ unsigned xb_xcc_id() { return (unsigned)__builtin_amdgcn_s_getreg((3 << 11) | 20) & 0xFu; }
#define XB_SPIN(cond, bar) do { unsigned _sp = 0; while (cond) { __builtin_amdgcn_s_sleep(1); \
    if ((++_sp & 255u) == 0u) { if (xb_ld(&(bar)[XB_TMO])) break; if (_sp > XB_SPIN_CAP) { atomicAdd(&(bar)[XB_TMO], 1u); break; } } } } while (0)

struct XcdBarrier {
    unsigned* bar; unsigned x; int tid;
    volatile LAS unsigned* st;
};

__device__ __forceinline__ XcdBarrier xcd_barrier_post(unsigned* bar, volatile LAS unsigned* st) {
    XcdBarrier b; b.bar = bar; b.x = xb_xcc_id(); b.st = st;
    if (threadIdx.x == 0) (void)xb_add(&bar[XB_XCNT(b.x)], 1u);
    return b;
}
__device__ __forceinline__ void xcd_barrier_complete(unsigned* bar, unsigned x, unsigned& nloc, unsigned& nx) {
    const unsigned G = gridDim.x * gridDim.y * gridDim.z;
    unsigned sum, cnt, mine, sp = 0u;
    for (;;) {
        sum = 0u; cnt = 0u; mine = 0u;
#pragma unroll
        for (unsigned j = 0; j < 16; ++j) { const unsigned c = xb_ld(&bar[XB_XCNT(j)]); sum += c; cnt += (c > 0u) ? 1u : 0u; mine = (j == x) ? c : mine; }
        if (sum == G) break;
        __builtin_amdgcn_s_sleep(1);
        if ((++sp & 255u) == 0u) { if (xb_ld(&bar[XB_TMO])) break; if (sp > XB_SPIN_CAP) { atomicAdd(&bar[XB_TMO], 1u); break; } }
    }
    nloc = mine > 0u ? mine : 1u; nx = cnt > 0u ? cnt : 1u;
}

__device__ __forceinline__ void xcd_barrier(const XcdBarrier& b) {
    asm volatile("s_waitcnt vmcnt(0)" ::: "memory");
    __syncthreads();
    if (b.tid == 0) {
        unsigned* bar = b.bar;
        __builtin_amdgcn_s_waitcnt(0);
        unsigned nloc = b.st[0], nx = b.st[1];
        if (nloc == 0u) { xcd_barrier_complete(bar, b.x, nloc, nx); b.st[0] = nloc; b.st[1] = nx; }
        const unsigned old = xb_add(&bar[XB_XSUB(b.x)], 1u);
        const unsigned gen = old / nloc;
        if (old + 1u == (gen + 1u) * nloc) {
            __builtin_amdgcn_fence(__ATOMIC_RELEASE, "agent");
            asm volatile("s_waitcnt vmcnt(0)" ::: "memory");
            const unsigned og = xb_add(&bar[XB_TOP], 1u);
            const unsigned tg = og / nx;
            if (og + 1u == (tg + 1u) * nx) xb_add(&bar[XB_TOPGEN], 1u);
            else XB_SPIN(xb_ld(&bar[XB_TOPGEN]) == tg, bar);
            __builtin_amdgcn_fence(__ATOMIC_ACQUIRE, "agent");
            xb_add(&bar[XB_XGEN(b.x)], 1u);
            asm volatile("s_waitcnt vmcnt(0)" ::: "memory");
        } else {
            XB_SPIN(xb_ld(&bar[XB_XGEN(b.x)]) == gen, bar);
            __builtin_amdgcn_fence(__ATOMIC_ACQUIRE, "agent");
            asm volatile("s_waitcnt vmcnt(0)" ::: "memory");
        }
    }
    __syncthreads();
}
#include <hip/hip_bf16.h>
#include <cmath>
namespace attn_body {
using bf16=__hip_bfloat16;
using bf16x8=__attribute__((ext_vector_type(8)))short;
using s16x4=__attribute__((ext_vector_type(4)))short;
using f32x16=__attribute__((ext_vector_type(16)))float;
using u32x4=__attribute__((ext_vector_type(4)))unsigned;
constexpr int BATCH=2,NHEAD=16,SEQ=8192,D=64,DM=NHEAD*D,KVP=256,GRP=4;
constexpr int NW=8,QBLK=32,QB=QBLK*NW,KVBLK=64,NQB=SEQ/QB;
constexpr int ATTN_PITCH=DM, ATTN_UNIT_ROWS=QB;
__device__ __forceinline__ int crow(int r,int hi){return (r&3)+8*(r>>2)+4*hi;}
#define SBAR() __builtin_amdgcn_sched_barrier(0)
__device__ __forceinline__ void cmask(f32x16&p0,f32x16&p1,int jb,int qrel,int hi){
  const float NEG=-INFINITY; int kb=64*jb+4*hi;
  #pragma unroll
  for(int r=0;r<16;++r){int kv=kb+(r&3)+8*(r>>2); if(kv>qrel)p0[r]=NEG; if(kv+32>qrel)p1[r]=NEG;}
}

constexpr int NSLOT=3, SLOTB=8192;
constexpr int LDS_K=0, LDS_V=NSLOT*SLOTB, LDS_WS=2*NSLOT*SLOTB, LDS_OST=LDS_WS+NW*64*4, LDS_BYTES=LDS_OST+NW*4096;
constexpr float C2=0.125f*1.4426950408889634f;
__device__ __forceinline__ void glds16(const void*gsrc,unsigned lds_dst){unsigned keep;
  asm volatile("s_mov_b32 %0, m0\n\ts_mov_b32 m0, %2\n\ts_nop 0\n\tglobal_load_lds_dwordx4 %1, off\n\ts_mov_b32 m0, %0":"=&s"(keep):"v"(gsrc),"s"(lds_dst):"memory");}
__device__ __forceinline__ float max3f(float a,float b,float c){float r;asm("v_max3_f32 %0, %1, %2, %3":"=v"(r):"v"(a),"v"(b),"v"(c));return r;}
__device__ __forceinline__ float max2f(float a,float b){float r;asm("v_max_f32_e32 %0, %1, %2":"=v"(r):"v"(a),"v"(b));return r;}
__device__ __forceinline__ float fadd_s(float a,float b){float r;asm("v_add_f32_e32 %0, %1, %2":"=v"(r):"v"(a),"v"(b));return r;}
__device__ __forceinline__ float fsub_s(float a,float b){float r;asm("v_sub_f32_e32 %0, %1, %2":"=v"(r):"v"(a),"v"(b));return r;}
typedef float f32x2_t __attribute__((ext_vector_type(2))); typedef __bf16 bf16x2_t __attribute__((ext_vector_type(2)));
__device__ __forceinline__ unsigned cvtpk_s(float lo,float hi){f32x2_t v={lo,hi};bf16x2_t b=__builtin_convertvector(v,bf16x2_t);return __builtin_bit_cast(unsigned,b);}
#define WAIT_BAR(N) asm volatile("s_waitcnt vmcnt(" #N ") lgkmcnt(0)\n\ts_barrier":::"memory")

__device__ __forceinline__ void qkt(f32x16&p0,f32x16&p1,const char*Kslot,const bf16x8*qr,const f32x16&negm,int r32,int hi){
  const char*kb=Kslot+hi*1024+r32*16;
  #pragma unroll
  for(int d0=0;d0<4;++d0){
    const bf16x8 b0=*reinterpret_cast<const bf16x8*>(kb+d0*2048);
    const bf16x8 b1=*reinterpret_cast<const bf16x8*>(kb+d0*2048+512);
    if(d0==0){p0=__builtin_amdgcn_mfma_f32_32x32x16_bf16(b0,qr[0],negm,0,0,0);p1=__builtin_amdgcn_mfma_f32_32x32x16_bf16(b1,qr[0],negm,0,0,0);}
    else{p0=__builtin_amdgcn_mfma_f32_32x32x16_bf16(b0,qr[d0],p0,0,0,0);p1=__builtin_amdgcn_mfma_f32_32x32x16_bf16(b1,qr[d0],p1,0,0,0);}}
}
typedef __attribute__((address_space(3))) const char* lds_cptr;
typedef short v4i16_t __attribute__((ext_vector_type(4)));
__device__ __forceinline__ void kload8(bf16x8*kf,lds_cptr kp){
  kf[0]=*(const __attribute__((address_space(3))) bf16x8*)(kp);      kf[1]=*(const __attribute__((address_space(3))) bf16x8*)(kp+512);
  kf[2]=*(const __attribute__((address_space(3))) bf16x8*)(kp+2048); kf[3]=*(const __attribute__((address_space(3))) bf16x8*)(kp+2560);
  kf[4]=*(const __attribute__((address_space(3))) bf16x8*)(kp+4096); kf[5]=*(const __attribute__((address_space(3))) bf16x8*)(kp+4608);
  kf[6]=*(const __attribute__((address_space(3))) bf16x8*)(kp+6144); kf[7]=*(const __attribute__((address_space(3))) bf16x8*)(kp+6656);
}
__device__ __forceinline__ void kload2(bf16x8*kf,lds_cptr kp,int j){ kf[2*j]=*(const __attribute__((address_space(3))) bf16x8*)(kp+j*2048); kf[2*j+1]=*(const __attribute__((address_space(3))) bf16x8*)(kp+j*2048+512); }
__device__ __forceinline__ s16x4 vtr(lds_cptr p){ return __builtin_bit_cast(s16x4,__builtin_amdgcn_ds_read_tr16_b64_v4i16((__attribute__((address_space(3))) v4i16_t*)p)); }
__device__ __forceinline__ float rowmax(const f32x16&p0,const f32x16&p1){
  float a=max3f(p0[0],p0[1],p1[0]),b=max3f(p0[2],p0[3],p1[1]);a=max3f(a,p1[2],p1[3]);
  #pragma unroll
  for(int r=4;r<16;r+=4){a=max3f(a,p0[r],p0[r+1]);b=max3f(b,p0[r+2],p0[r+3]);a=max3f(a,p1[r],p1[r+1]);b=max3f(b,p1[r+2],p1[r+3]);}
  const float m=max2f(a,b);
  auto rr=__builtin_amdgcn_permlane32_swap(__float_as_uint(m),__float_as_uint(m),false,false);
  return max2f(__uint_as_float(rr[0]),__uint_as_float(rr[1]));
}
__device__ __forceinline__ void pv(f32x16*o,int vb,bf16x8 pa0,bf16x8 pa1,bf16x8 pa2,bf16x8 pa3){
  #pragma unroll
  for(int d0=0;d0<2;++d0){s16x4 lo[4],hi[4];
    #pragma unroll
    for(int ks=0;ks<4;++ks){
      asm volatile("ds_read_b64_tr_b16 %0,%1 offset:%c2":"=&v"(lo[ks]):"v"(vb),"i"(d0*4096+ks*1024):"memory");
      asm volatile("ds_read_b64_tr_b16 %0,%1 offset:%c2":"=&v"(hi[ks]):"v"(vb),"i"(d0*4096+ks*1024+512):"memory");}
    asm volatile("s_waitcnt lgkmcnt(0)":::"memory");SBAR();
    #define PK(k) (bf16x8){lo[k][0],lo[k][1],lo[k][2],lo[k][3],hi[k][0],hi[k][1],hi[k][2],hi[k][3]}
    o[d0]=__builtin_amdgcn_mfma_f32_32x32x16_bf16(pa0,PK(0),o[d0],0,0,0);
    o[d0]=__builtin_amdgcn_mfma_f32_32x32x16_bf16(pa1,PK(1),o[d0],0,0,0);
    o[d0]=__builtin_amdgcn_mfma_f32_32x32x16_bf16(pa2,PK(2),o[d0],0,0,0);
    o[d0]=__builtin_amdgcn_mfma_f32_32x32x16_bf16(pa3,PK(3),o[d0],0,0,0);
    #undef PK
  }
}

#ifndef ATTN_STORE16
#define ATTN_STORE16(p,v) (*(u32x4*)(p)=(v))
#endif
struct NoHook { int mode=0; __device__ __forceinline__ void begin_unit(){} __device__ __forceinline__ void issue(int){} __device__ __forceinline__ void consume(int){} __device__ __forceinline__ void advance(bool){} };
template<int THRL,class Hook> __device__ __forceinline__ void attn_unit(int b,int h,int qb,const bf16*Q,const bf16*__restrict__ K,const bf16*__restrict__ V,bf16*O,char*shm,const int tid_in,const float Mref,Hook&hk){
  const int tid=tid_in,lane=tid&63,r32=lane&31,hi=lane>>5; const int wid=__builtin_amdgcn_readfirstlane(tid>>6);
  const long rowbase=(long)b*SEQ; const int q0=qb*QB;
  const bf16*Qw=Q+(rowbase+q0+wid*QBLK)*DM+h*D;
  const bf16*Kh=K+rowbase*KVP+(h/GRP)*D,*Vh=V+rowbase*KVP+(h/GRP)*D;
  const unsigned lds0=(unsigned)(uintptr_t)shm;
  float*wsf=(float*)(shm+LDS_WS)+wid*64;
  const bf16*ksrc=Kh+(long)lane*KVP+wid*8;
  const bf16*vsrc=Vh+(long)(16*(wid&3)+(lane>>2))*KVP+(wid>>2)*32+(lane&3)*8;
  const unsigned kdst=lds0+LDS_K+wid*1024, vdst=lds0+LDS_V+wid*1024;
  #define DMA_K(t,slot) glds16(ksrc+(long)(t)*KVBLK*KVP,(unsigned)__builtin_amdgcn_readfirstlane(kdst+(slot)))
  #define DMA_V(t,slot) glds16(vsrc+(long)(t)*KVBLK*KVP,(unsigned)__builtin_amdgcn_readfirstlane(vdst+(slot)))
  const int vb0=(int)(lds0+LDS_V)+((lane>>4)&1)*32+(lane&3)*8+(4*hi+((lane&15)>>2))*64;
  const char*Kbase=shm+LDS_K; bf16x8 kf[8];
  const lds_cptr shm3=(lds_cptr)shm; const lds_cptr kp0=shm3+LDS_K+hi*1024+r32*16; const lds_cptr vp0=shm3+LDS_V+((lane>>4)&1)*32+(lane&3)*8+(4*hi+((lane&15)>>2))*64;
  const int NT=SEQ/KVBLK;
  DMA_K(0,0);DMA_V(0,0);DMA_K(1,SLOTB);
  bf16x8 qr[4];
  #pragma unroll
  for(int d0=0;d0<4;++d0)qr[d0]=*reinterpret_cast<const bf16x8*>(&Qw[(long)r32*DM+d0*16+hi*8]);
  float l_reg=0.f;f32x16 o[2];o[0]=f32x16{};o[1]=f32x16{};f32x16 negm;
  _Pragma("unroll") for(int r=0;r<16;++r)negm[r]=-Mref;asm volatile("":"+v"(negm));
  const int qrel=wid*QBLK+r32;
  #define CMASK(P0,P1,t) do{}while(0)
  #define START(P0,P1) do{ _Pragma("unroll") for(int r=0;r<16;++r)P0[r]=__builtin_amdgcn_exp2f(P0[r]); }while(0)
  #define RESC() do{}while(0)
  f32x16 pA0,pA1,pB0,pB1;
  int sl_prev=0,sl_cur=0,sl_next=SLOTB;
  #define ROT() do{sl_prev=sl_cur;sl_cur=sl_next;sl_next=(sl_next==(NSLOT-1)*SLOTB)?0:sl_next+SLOTB;}while(0)
  DMA_K(2,2*SLOTB);
  WAIT_BAR(3);
  qkt(pA0,pA1,Kbase,qr,negm,r32,hi);asm volatile("s_nop 15\n\ts_nop 7":"+v"(pA0),"+v"(pA1));CMASK(pA0,pA1,0);
  START(pA0,pA1);
  _Pragma("unroll") for(int r=0;r<16;++r)pA1[r]=__builtin_amdgcn_exp2f(pA1[r]);
  WAIT_BAR(0);
  DMA_K(3,0);DMA_V(1,SLOTB);
  ROT();
  kload8(kf,kp0+sl_cur);
  WAIT_BAR(2);
  s16x4 vlo[8],vhi[8]; u32x4 pw0,pw1,pw2,pw3;
  #define PKW(P,B) cvtpk_s(P[B],P[B+1])
  #define PAF(k) __builtin_bit_cast(bf16x8,pw##k)
  #define VFR(i) (bf16x8){vlo[i][0],vlo[i][1],vlo[i][2],vlo[i][3],vhi[i][0],vhi[i][1],vhi[i][2],vhi[i][3]}
  #define PIN(x) asm volatile("":"+v"(x))
  #define MX3(a,b,c) __builtin_fmaxf(__builtin_fmaxf((a),(b)),(c))
  #define GAPA(MF,A0,A1,A2,A3,W0,W1,PW) do{ MF; sacc+=A0; sacc+=A1; sacc+=A2; sacc+=A3; PIN(sacc); W0; W1; PIN(PW); SBAR(); }while(0)
  #define EX(v) __builtin_amdgcn_exp2f(v)
  #define GAPB(MF,X,B) do{ MF; X[B]=EX(X[B]); X[B+1]=EX(X[B+1]); X[B+2]=EX(X[B+2]); X[B+3]=EX(X[B+3]); PIN(X); SBAR(); }while(0)
  #define VRD(i) do{ vlo[i]=vtr(vp_+(((i)>>2)*4096+((i)&3)*1024)); vhi[i]=vtr(vp_+(((i)>>2)*4096+((i)&3)*1024+512)); }while(0)
  #define KRD(G,j) do{ if(G){ kload2(kf,kp0+sl_next,j); SBAR(); } }while(0)
  #define STEP(C0,C1,P0,P1,t,GK,GV,GL,HK) do{ SBAR(); \
    const lds_cptr vp_=vp0+sl_prev; \
    VRD(0); SBAR(); float sacc=(P0[0]+P0[1]); \
    GAPA(C0=__builtin_amdgcn_mfma_f32_32x32x16_bf16(kf[0],qr[0],negm,0,0,0), P0[2],P0[3],P0[4],P0[5],     pw0[0]=PKW(P0,0), pw0[1]=PKW(P0,2), pw0); \
    VRD(4); SBAR(); GAPA(C1=__builtin_amdgcn_mfma_f32_32x32x16_bf16(kf[1],qr[0],negm,0,0,0), P0[6],P0[7],P0[8],P0[9],     pw0[2]=PKW(P0,4), pw0[3]=PKW(P0,6), pw0); \
    VRD(1); SBAR(); GAPA(C0=__builtin_amdgcn_mfma_f32_32x32x16_bf16(kf[2],qr[1],C0,0,0,0),   P0[10],P0[11],P0[12],P0[13], pw1[0]=PKW(P0,8), pw1[1]=PKW(P0,10), pw1); \
    VRD(5); SBAR(); GAPA(C1=__builtin_amdgcn_mfma_f32_32x32x16_bf16(kf[3],qr[1],C1,0,0,0),   P0[14],P0[15],P1[0],P1[1],   pw1[2]=PKW(P0,12),pw1[3]=PKW(P0,14), pw1); \
    VRD(2); SBAR(); GAPA(C0=__builtin_amdgcn_mfma_f32_32x32x16_bf16(kf[4],qr[2],C0,0,0,0),   P1[2],P1[3],P1[4],P1[5],     pw2[0]=PKW(P1,0), pw2[1]=PKW(P1,2), pw2); \
    VRD(6); SBAR(); GAPA(C1=__builtin_amdgcn_mfma_f32_32x32x16_bf16(kf[5],qr[2],C1,0,0,0),   P1[6],P1[7],P1[8],P1[9],     pw2[2]=PKW(P1,4), pw2[3]=PKW(P1,6), pw2); \
    VRD(3); SBAR(); GAPA(C0=__builtin_amdgcn_mfma_f32_32x32x16_bf16(kf[6],qr[3],C0,0,0,0),   P1[10],P1[11],P1[12],P1[13], pw3[0]=PKW(P1,8), pw3[1]=PKW(P1,10), pw3); \
    VRD(7); SBAR(); GAPA(C1=__builtin_amdgcn_mfma_f32_32x32x16_bf16(kf[7],qr[3],C1,0,0,0),   P1[14],P1[15],0.f,0.f,       pw3[2]=PKW(P1,12),pw3[3]=PKW(P1,14), pw3); \
    l_reg+=sacc; \
    if(GK){DMA_K((t)+3,sl_cur);} if(GV){DMA_V((t)+1,sl_next);} if(HK){ if(hk.mode==1) hk.issue(lane); } \
    CMASK(C0,C1,t); \
    SBAR(); \
    GAPB(o[0]=__builtin_amdgcn_mfma_f32_32x32x16_bf16(PAF(0),VFR(0),o[0],0,0,0), C0,0); \
    GAPB(o[1]=__builtin_amdgcn_mfma_f32_32x32x16_bf16(PAF(0),VFR(4),o[1],0,0,0), C0,4); \
    KRD(GL,0); GAPB(o[0]=__builtin_amdgcn_mfma_f32_32x32x16_bf16(PAF(1),VFR(1),o[0],0,0,0), C0,8); \
    KRD(GL,1); GAPB(o[1]=__builtin_amdgcn_mfma_f32_32x32x16_bf16(PAF(1),VFR(5),o[1],0,0,0), C0,12); \
    KRD(GL,2); GAPB(o[0]=__builtin_amdgcn_mfma_f32_32x32x16_bf16(PAF(2),VFR(2),o[0],0,0,0), C1,0); \
    KRD(GL,3); GAPB(o[1]=__builtin_amdgcn_mfma_f32_32x32x16_bf16(PAF(2),VFR(6),o[1],0,0,0), C1,4); \
    GAPB(o[0]=__builtin_amdgcn_mfma_f32_32x32x16_bf16(PAF(3),VFR(3),o[0],0,0,0), C1,8); \
    GAPB(o[1]=__builtin_amdgcn_mfma_f32_32x32x16_bf16(PAF(3),VFR(7),o[1],0,0,0), C1,12); \
    }while(0)
  int t=1;
  #undef CMASK
  #define CMASK(P0,P1,t) do{}while(0)
  hk.begin_unit();
  for(;t+5<NT&&hk.mode!=0;t+=2){
    STEP(pB0,pB1,pA0,pA1,t,true,true,true,1);     if(hk.mode==1){WAIT_BAR(6);}else{WAIT_BAR(2);} RESC(); ROT();
    if(hk.mode==2) hk.consume(lane);
    STEP(pA0,pA1,pB0,pB1,t+1,true,true,true,0);   if(hk.mode==1){WAIT_BAR(6);}else{WAIT_BAR(2);} RESC(); ROT();
    hk.advance(t+9<NT);
  }
  for(;t+5<NT;t+=2){
    STEP(pB0,pB1,pA0,pA1,t,true,true,true,0);     WAIT_BAR(2); RESC(); ROT();
    STEP(pA0,pA1,pB0,pB1,t+1,true,true,true,0);   WAIT_BAR(2); RESC(); ROT();
  }
  #undef CMASK
  #define CMASK(P0,P1,t) do{}while(0)
  #define ENDW(tt) do{ if((tt)+3<NT){WAIT_BAR(2);} else if((tt)+2<NT){WAIT_BAR(1);} else {WAIT_BAR(0);} }while(0)
  for(;t+1<NT;t+=2){
    STEP(pB0,pB1,pA0,pA1,t,(t+3<NT),(t+1<NT),(t+1<NT),0);       ENDW(t);   RESC(); ROT();
    STEP(pA0,pA1,pB0,pB1,t+1,(t+4<NT),(t+2<NT),(t+2<NT),0);     ENDW(t+1); RESC(); ROT();
  }
  STEP(pB0,pB1,pA0,pA1,NT-1,false,false,false,0); RESC();
  { float sacc=pB0[0]+pB0[1]; _Pragma("unroll") for(int r=2;r<16;++r)sacc+=pB0[r]; _Pragma("unroll") for(int r=0;r<16;++r)sacc+=pB1[r]; l_reg+=sacc;
    pw0=(u32x4){PKW(pB0,0),PKW(pB0,2),PKW(pB0,4),PKW(pB0,6)};pw1=(u32x4){PKW(pB0,8),PKW(pB0,10),PKW(pB0,12),PKW(pB0,14)};pw2=(u32x4){PKW(pB1,0),PKW(pB1,2),PKW(pB1,4),PKW(pB1,6)};pw3=(u32x4){PKW(pB1,8),PKW(pB1,10),PKW(pB1,12),PKW(pB1,14)};
    SBAR(); pv(o,vb0+sl_cur,PAF(0),PAF(1),PAF(2),PAF(3)); }
  #undef PKW
  #undef PAF
  #undef VFR
  #undef PIN
  #undef MX3
  #undef GAPA
  #undef GAPB
  #undef EX
  #undef VRD
  #undef KRD
  #undef STEP
  #undef ENDW
  {auto rr=__builtin_amdgcn_permlane32_swap(__float_as_uint(l_reg),__float_as_uint(l_reg),false,false);l_reg=__uint_as_float(rr[0])+__uint_as_float(rr[1]);}
  if(hi==0)wsf[32+r32]=l_reg;asm volatile("s_waitcnt lgkmcnt(0)":::"memory");
  float rli[16];
  #pragma unroll
  for(int r=0;r<16;++r)rli[r]=__builtin_amdgcn_rcpf(wsf[32+crow(r,hi)]);
  bf16*Ow=O+(rowbase+q0+wid*QBLK)*DM+h*D;
  { bf16*stg=(bf16*)(shm+LDS_OST)+wid*2048;
    #pragma unroll
    for(int r=0;r<16;++r){const int orow=crow(r,hi);
      #pragma unroll
      for(int d0=0;d0<2;++d0)stg[orow*64+d0*32+r32]=__float2bfloat16(o[d0][r]*rli[r]);}
    asm volatile("s_waitcnt lgkmcnt(0)":::"memory");
    #pragma unroll
    for(int i=0;i<4;++i){const int row=i*8+(lane>>3),ch=lane&7; const u32x4 v=*(const u32x4*)(stg+row*64+ch*8); ATTN_STORE16(Ow+(long)row*DM+ch*8,v);} }
  asm volatile("s_waitcnt lgkmcnt(0)\n\ts_barrier":::"memory");
  #undef DMA_K
  #undef DMA_V
  #undef CMASK
  #undef START
  #undef RESC
  #undef ROT
}
constexpr int ATTN_LDS_BYTES=LDS_BYTES;
struct AttnTensors { const bf16* Q; const bf16* K; const bf16* V; bf16* O; float Mref; };
struct AttnUnit { int bh; int qb; };
struct StaticOrder {
  int vcu;
  __device__ __forceinline__ explicit StaticOrder(int grid,int block):vcu((block%8)*(grid/8)+block/8){}
  __device__ __forceinline__ bool next(int i,AttnUnit&u)const{ if(i>=4)return false; const int s=vcu&7; u.bh=vcu>>3; u.qb=(i==0)?s:(i==1)?15-s:(i==2)?16+s:31-s; return true; }
  __device__ __forceinline__ void a_ready(const AttnUnit&)const{}
  __device__ __forceinline__ void done(const AttnUnit&)const{}
};
template<class Sched,int THRL=8> __device__ __forceinline__ void attn_phase(char*lds,const AttnTensors&T,const Sched&S,const int tid_in){
  AttnUnit u;
  NoHook nh; for(int i=0;S.next(i,u);++i){ S.a_ready(u); attn_unit<THRL,NoHook>(u.bh/NHEAD,u.bh%NHEAD,u.qb,T.Q,T.K,T.V,T.O,lds,tid_in,T.Mref,nh); S.done(u); }
}
#undef SBAR
#undef WAIT_BAR
}

namespace pg8 { typedef EpiQKV<0, (unsigned)WS_QAB, (unsigned)WS_KA, (unsigned)WS_VA, (unsigned)WS_KVB> EpiQKV0; typedef EpiQKV<1, (unsigned)WS_Q1, (unsigned)WS_K1, (unsigned)WS_V1, 0u> EpiQKV1; }
#define DI __device__ __forceinline__
struct Args { const float* in[21]; float* out; unsigned char* ws; int ph_lo, ph_hi; };
typedef const __attribute__((address_space(4))) Args* KArgs;
struct Frame {
    LAS unsigned char* lds;
    volatile LAS unsigned* MISC;
    gu32* ctl;
    int tid, lane, wave, vcu, G;
    unsigned char* ws;
    KArgs a;
    float* out;
};
enum { I_X = 0, I_MIXN, I_FFNN, I_ABWIN, I_AQN, I_AKN, I_BQN, I_BKN, I_BSINK, I_ABWOUT, I_CWIN, I_CQN, I_CKN, I_CWOUT, I_MGW, I_MGB, I_MEW, I_MEB, I_WGATE, I_WUP, I_WDOWN };

template <int PAT> DI float swz_f(float v) { return __builtin_bit_cast(float, __builtin_amdgcn_ds_swizzle(__builtin_bit_cast(int, v), PAT)); }
template <int CTRL> DI float dpp_f(float v) { return __builtin_bit_cast(float, __builtin_amdgcn_update_dpp(0, __builtin_bit_cast(int, v), CTRL, 0xf, 0xf, true)); }
DI float xor1_f(float v) { return dpp_f<0xB1>(v); }
DI float xor2_f(float v) { return dpp_f<0x4E>(v); }
DI float wave_sum(float v) {
    v += xor1_f(v); v += xor2_f(v);
    v += dpp_f<0x141>(v);
    v += dpp_f<0x140>(v);
    const float s0 = __builtin_bit_cast(float, __builtin_amdgcn_readlane(__builtin_bit_cast(int, v), 0)), s1 = __builtin_bit_cast(float, __builtin_amdgcn_readlane(__builtin_bit_cast(int, v), 16));
    const float s2 = __builtin_bit_cast(float, __builtin_amdgcn_readlane(__builtin_bit_cast(int, v), 32)), s3 = __builtin_bit_cast(float, __builtin_amdgcn_readlane(__builtin_bit_cast(int, v), 48));
    return (s0 + s1) + (s2 + s3);
}
DI float bf2f(unsigned short b) { return __builtin_bit_cast(float, (unsigned)b << 16); }

DI void tr_item(const float* W, int N, bf16* WT, int dstK, int drow, LAS float* scr, int k0, int n0, int lane) {
    const int r8 = lane >> 3, c4 = (lane & 7) * 4;
    f32x4 v[8];
#pragma unroll
    for (int i = 0; i < 8; ++i) v[i] = __builtin_nontemporal_load((const GAS f32x4*)(W + (size_t)(k0 + 8 * i + r8) * N + n0 + c4));
#pragma unroll
    for (int i = 0; i < 8; ++i) { LAS float* d = scr + (8 * i + r8) * 33 + c4; d[0] = v[i].x; d[1] = v[i].y; d[2] = v[i].z; d[3] = v[i].w; }
    LDS_WAIT(); asm volatile("" ::: "memory");
    const int c = lane & 7;
#pragma unroll
    for (int j = 0; j < 4; ++j) { const int n = (lane >> 3) + 8 * j; const LAS float* s = scr + (8 * c) * 33 + n;
        v4u o; o.x = pk2(s[0 * 33], s[1 * 33]); o.y = pk2(s[2 * 33], s[3 * 33]); o.z = pk2(s[4 * 33], s[5 * 33]); o.w = pk2(s[6 * 33], s[7 * 33]);
        *(GAS v4u*)(WT + (size_t)(drow + n) * dstK + k0 + 8 * c) = o; }
    LDS_WAIT(); asm volatile("" ::: "memory");
}
DI void load_row16(const float* row, int lane, f32x4 (&v)[4]) {
    const GAS f32x4* xr = (const GAS f32x4*)row + lane;
#pragma unroll
    for (int j = 0; j < 4; ++j) v[j] = xr[64 * j];
}
DI float row_rinv(const f32x4 (&v)[4]) {
    float s = 0.f;
#pragma unroll
    for (int j = 0; j < 4; ++j) s += (v[j].x * v[j].x + v[j].y * v[j].y) + (v[j].z * v[j].z + v[j].w * v[j].w);
    return 1.0f / sqrtf(wave_sum(s) * (1.f / D) + RMS_EPS);
}
DI void row_norm_store(f32x4 (&v)[4], float rinv, const float* g, bf16* orow, int lane) {
    const GAS f32x4* gr = (const GAS f32x4*)g + lane;
    GAS unsigned long long* o8 = (GAS unsigned long long*)orow + lane;
#pragma unroll
    for (int j = 0; j < 4; ++j) { const f32x4 gg = gr[64 * j]; v[j] = v[j] * rinv * gg;
        o8[64 * j] = (unsigned long long)pk2(v[j].x, v[j].y) | ((unsigned long long)pk2(v[j].z, v[j].w) << 32); }
}
DI void row_norm_store_g(f32x4 (&v)[4], float rinv, const f32x4 (&gg)[4], bf16* orow, int lane) {
    GAS unsigned long long* o8 = (GAS unsigned long long*)orow + lane;
#pragma unroll
    for (int j = 0; j < 4; ++j) { v[j] = v[j] * rinv * gg[j];
        o8[64 * j] = (unsigned long long)pk2(v[j].x, v[j].y) | ((unsigned long long)pk2(v[j].z, v[j].w) << 32); }
}
#ifndef WCONV_IN_ATTN
#define WCONV_IN_ATTN 1
#endif
constexpr int MOE_WITEMS_ALL = 3 * 64 * 128;
constexpr int MOE_WITEMS = WCONV_IN_ATTN ? MOE_WITEMS_ALL / 2 : 0;
DI void moe_weight_item(Frame& F, int r, LAS float* scr) {
    constexpr int IE = 64 * 128;
    if (r < 2 * IE) {
        const int up = r >= IE ? 1 : 0; r -= up * IE;
        const int mat = r >> 7, itx = r & 127, kb = itx >> 3, nb = itx & 7, l = mat >> 5, E = mat & 31, n0 = 32 * nb;
        const float* src = F.a->in[up ? I_WUP : I_WGATE] + (size_t)mat * 262144;
        bf16* dst = (bf16*)(F.ws + WS_WGU) + (size_t)l * (32 * 512 * 1024);
        tr_item(src, 256, dst, 1024, E * 512 + (n0 >> 7) * 256 + (n0 & 127) + up * 128, scr, 64 * kb, n0, F.lane);
    } else {
        r -= 2 * IE;
        const int mat = r >> 7, itx = r & 127, kb = itx >> 5, nb = itx & 31, l = mat >> 5, E = mat & 31, n0 = 32 * nb;
        const float* src = F.a->in[I_WDOWN] + (size_t)mat * 262144;
        bf16* dst = (bf16*)(F.ws + WS_WD) + (size_t)l * (32 * 1024 * 256);
        tr_item(src, 1024, dst, 256, E * 1024 + n0, scr, 64 * kb, n0, F.lane);
    }
}
struct WHalf { const float* src; bf16* dst; int N, dstK, drow, k0, n0; };
constexpr int WSUB_L = MOE_WITEMS_ALL;
DI WHalf moe_weight_half(Frame& F, int sub) {
    constexpr int IE = 64 * 128; WHalf d; int r = sub >> 1; const int kh = sub & 1;
    if (r < 2 * IE) {
        const int up = r >= IE ? 1 : 0; r -= up * IE;
        const int mat = r >> 7, itx = r & 127, kb = itx >> 3, nb = itx & 7, l = mat >> 5, E = mat & 31, n0 = 32 * nb;
        d.src = F.a->in[up ? I_WUP : I_WGATE] + (size_t)mat * 262144; d.dst = (bf16*)(F.ws + WS_WGU) + (size_t)l * (32 * 512 * 1024);
        d.N = 256; d.dstK = 1024; d.drow = E * 512 + (n0 >> 7) * 256 + (n0 & 127) + up * 128; d.k0 = 64 * kb + 32 * kh; d.n0 = n0;
    } else {
        r -= 2 * IE;
        const int mat = r >> 7, itx = r & 127, kb = itx >> 5, nb = itx & 31, l = mat >> 5, E = mat & 31, n0 = 32 * nb;
        d.src = F.a->in[I_WDOWN] + (size_t)mat * 262144; d.dst = (bf16*)(F.ws + WS_WD) + (size_t)l * (32 * 1024 * 256);
        d.N = 1024; d.dstK = 256; d.drow = E * 1024 + n0; d.k0 = 64 * kb + 32 * kh; d.n0 = n0;
    }
    return d;
}
DI int witem_of_layer(int l, int j) { return ((j >> 12) << 13) + (l << 12) + (j & 4095); }
DI int wsub_of_layer(int l, int j) { return 2 * witem_of_layer(l, j >> 1) + (j & 1); }
constexpr int WH_BLK = 1088, WH_SCR_BYTES = 4 * WH_BLK;
DI void wh_glds16(const void* gsrc, unsigned lds_dst) { unsigned keep;
    asm volatile("s_mov_b32 %0, m0\n\ts_mov_b32 m0, %2\n\ts_nop 0\n\tglobal_load_lds_dwordx4 %1, off nt\n\ts_mov_b32 m0, %0" : "=&s"(keep) : "v"(gsrc), "s"(lds_dst) : "memory"); }
DI void wh_issue(const WHalf& d, int lane, unsigned scr_lds) {
    const float* p = d.src + (size_t)(d.k0 + (lane >> 3)) * d.N + d.n0 + (lane & 7) * 4;
#pragma unroll
    for (int i = 0; i < 4; ++i) wh_glds16(p + (size_t)(8 * i) * d.N, scr_lds + i * WH_BLK);
}
DI void wh_finish(const WHalf& d, int lane, const LAS float* scr) {
    const int c = lane & 3;
#pragma unroll
    for (int j = 0; j < 2; ++j) { const int n = (lane >> 2) + 16 * j; const LAS float* s = scr + c * (WH_BLK / 4) + n;
        v4u o; o.x = pk2(s[0 * 32], s[1 * 32]); o.y = pk2(s[2 * 32], s[3 * 32]); o.z = pk2(s[4 * 32], s[5 * 32]); o.w = pk2(s[6 * 32], s[7 * 32]);
        *(GAS v4u*)(d.dst + (size_t)(d.drow + n) * d.dstK + d.k0 + 8 * c) = o; }
    LDS_WAIT(); asm volatile("" ::: "memory");
}
constexpr int WS_PER_UNIT = 3;
struct DenseWStream {
    Frame* F; int j, stride, left, mode; LAS float* scr; unsigned scr_lds;
    DI void begin_unit() { left = WS_PER_UNIT; mode = (WCONV_IN_ATTN && j < WSUB_L) ? 1 : 0; }
    DI void issue(int lane) { asm volatile("" : "+v"(lane));     const WHalf wd = moe_weight_half(*F, wsub_of_layer(1, j)); wh_issue(wd, lane, scr_lds); }
    DI void consume(int lane) { asm volatile("" : "+v"(lane)); const WHalf wd = moe_weight_half(*F, wsub_of_layer(1, j)); wh_finish(wd, lane, scr); j += stride; --left; }
    DI void advance(bool can_start) { mode = mode == 1 ? 2 : ((left > 0 && j < WSUB_L && can_start) ? 1 : 0); }
};
DI void p_prologue(Frame& F) {
    LAS float* scr = (LAS float*)(F.lds + RING_OFF + F.wave * 16384);
    const int gw = F.vcu * NWAVES + F.wave, NGW = F.G * NWAVES;
    constexpr int I0 = 16 * 72, I1 = 16 * 32, I2 = 16 * 48, I3 = 16 * 32;
    constexpr int NITEMS = I0 + I1 + I2 + I3;
    f32x4 v0[4][4];
#pragma unroll
    for (int i = 0; i < 4; ++i) if (gw + i * NGW < M) load_row16(F.a->in[I_X] + (size_t)(gw + i * NGW) * D, F.lane, v0[i]);
    for (int it = gw; it < NITEMS; it += NGW) {
        int r = it;
        if (r < I0) { tr_item(F.a->in[I_ABWIN], AB_PROJ, (bf16*)(F.ws + WS_WABIN), 1024, pg8::qkv_drow(32 * (r % 72)), scr, 64 * (r / 72), 32 * (r % 72), F.lane); continue; } r -= I0;
        if (r < I1) { tr_item(F.a->in[I_ABWOUT], 1024, (bf16*)(F.ws + WS_WABOUT), 1024, 32 * (r % 32), scr, 64 * (r / 32), 32 * (r % 32), F.lane); continue; } r -= I1;
        if (r < I2) { tr_item(F.a->in[I_CWIN], C_PROJ, (bf16*)(F.ws + WS_WCIN), 1024, pg8::qkv_drow(32 * (r % 48)), scr, 64 * (r / 48), 32 * (r % 48), F.lane); continue; } r -= I2;
        tr_item(F.a->in[I_CWOUT], 1024, (bf16*)(F.ws + WS_WCOUT), 1024, 32 * (r % 32), scr, 64 * (r / 32), 32 * (r % 32), F.lane);
    }
    if (!WCONV_IN_ATTN) for (int it = gw; it < MOE_WITEMS_ALL; it += NGW) moe_weight_item(F, it, scr);
    float* cst = (float*)(F.ws + WS_CONST);
    {
        const int gt = (NGW - 1 - gw) * 64 + F.lane;
        if (gt < 3072) {
            const int isc = gt >= 2048 ? 1 : 0, e = isc ? gt - 2048 : gt, pos = e >> 4, i = e & 15;
            const float invf = exp2f(-(float)(2 * i) * (1.0f / 32.0f) * 13.287712379549449f);
            const float ang = (float)pos * invf;
            float* t = cst + 1024 + (isc ? 4096 : 0) + (size_t)pos * 32 + i;
            t[0] = cosf(ang); t[16] = sinf(ang);
        }
        if (gt == 4096) {
            float aq = 0.f, ak = 0.f, bq = 0.f, bk = 0.f, cq = 0.f, ck = 0.f;
            for (int i = 0; i < 64; ++i) { aq = fmaxf(aq, fabsf(F.a->in[I_AQN][i])); ak = fmaxf(ak, fabsf(F.a->in[I_AKN][i])); bq = fmaxf(bq, fabsf(F.a->in[I_BQN][i]));
                bk = fmaxf(bk, fabsf(F.a->in[I_BKN][i])); cq = fmaxf(cq, fabsf(F.a->in[I_CQN][i])); ck = fmaxf(ck, fabsf(F.a->in[I_CKN][i])); }
            cst[0] = 8.0f * aq * ak * LOG2E * 1.02f;
            const float mb = 8.0f * bq * bk * LOG2E * 1.02f;
            for (int h = 0; h < 8; ++h) cst[1 + h] = fmaxf(mb, F.a->in[I_BSINK][h] * LOG2E);
            cst[9] = 8.0f * cq * ck * LOG2E * 1.02f;
        }
    }
    {
        f32x4* rt = (f32x4*)(F.ws + WS_CONST + 65536);
        for (int idx = ((gw + NGW - (NGW * 9) / 16) % NGW) * 64 + F.lane; idx < 2 * 9216; idx += F.G * NWAVES * 64) {
            const int L = idx / 9216, r = idx % 9216;
            if (r < 1024) { const int l = r & 63, jc = r >> 6, k = 4 * (l + 64 * (jc >> 2)) + (jc & 3); rt[idx] = ((const f32x4*)(F.a->in[I_MGW] + (size_t)L * 4096))[k]; }
            else { const int q = r - 1024, g = q >> 11, t = q & 2047, l = t & 63, hh = (t >> 6) & 1, jc = t >> 7, k = 4 * (l + 64 * (jc >> 2)) + (jc & 3);
                rt[idx] = ((const f32x4*)(F.a->in[I_MEW] + (size_t)(L * 4 + g) * 8192))[2 * k + hh]; }
        }
    }
    {
        f32x4 gg[4]; { const GAS f32x4* gr = (const GAS f32x4*)F.a->in[I_MIXN] + F.lane;
#pragma unroll
            for (int j = 0; j < 4; ++j) gg[j] = gr[64 * j]; }
        for (int m = gw; m < M; m += 4 * NGW) {
            f32x4 v[4][4];
#pragma unroll
            for (int i = 0; i < 4; ++i) if (m + i * NGW < M) { if (m == gw) {
#pragma unroll
                    for (int j = 0; j < 4; ++j) v[i][j] = v0[i][j]; } else load_row16(F.a->in[I_X] + (size_t)(m + i * NGW) * D, F.lane, v[i]); }
#pragma unroll
            for (int i = 0; i < 4; ++i) if (m + i * NGW < M) { const float rinv = row_rinv(v[i]); row_norm_store_g(v[i], rinv, gg, (bf16*)(F.ws + WS_XN) + (size_t)(m + i * NGW) * D, F.lane); }
        }
    }
}

namespace att {
using bf16x8 = __attribute__((ext_vector_type(8))) short;
using s16x4 = __attribute__((ext_vector_type(4))) short;
using f32x16 = __attribute__((ext_vector_type(16))) float;
using u32x4 = __attribute__((ext_vector_type(4))) unsigned;
typedef __attribute__((address_space(3))) const char* lds_cptr;
typedef short v4i16_t __attribute__((ext_vector_type(4)));
typedef float f32x2_t __attribute__((ext_vector_type(2))); typedef __bf16 bf16x2_t __attribute__((ext_vector_type(2)));
DI int crow(int r, int hi) { return (r & 3) + 8 * (r >> 2) + 4 * hi; }
DI s16x4 vtr(lds_cptr p) { return __builtin_bit_cast(s16x4, __builtin_amdgcn_ds_read_tr16_b64_v4i16((__attribute__((address_space(3))) v4i16_t*)p)); }
DI unsigned cvtpk(float lo, float hi) { f32x2_t v = {lo, hi}; bf16x2_t b = __builtin_convertvector(v, bf16x2_t); return __builtin_bit_cast(unsigned, b); }
#define MFMA32(a, b, c) __builtin_amdgcn_mfma_f32_32x32x16_bf16((a), (b), (c), 0, 0, 0)

DI void load_q(bf16x8 (&qf)[4], const unsigned short* Q, int qpitch, int tq, int hi) {
    const unsigned short* qp = Q + (size_t)tq * qpitch + 8 * hi;
#pragma unroll
    for (int d0 = 0; d0 < 4; ++d0) qf[d0] = *(const bf16x8*)(qp + 16 * d0);
}
}

namespace att {
template <int NSUB, bool EDGE>
DI void band_run_t(f32x16 (&o)[2], f32x16& lsum, const bf16x8 (&qf)[4], const unsigned short* Kb, const unsigned short* Vb, const int kvpitch,
                   const int ktok0, const int dil, const float slope2d, const float negM, LAS unsigned char* vst, const int lane) {
    constexpr int HALFW = 16 * (NSUB - 1), SMID = (NSUB - 1) / 2;
    int ln_ = lane; asm volatile("" : "+v"(ln_));
    const int r32 = ln_ & 31, hi = ln_ >> 5;
    const lds_cptr vrd = (lds_cptr)vst + ((ln_ >> 4) & 1) * 32 + (ln_ & 3) * 8 + (4 * hi + ((ln_ & 15) >> 2)) * 64;
    const short one = (short)0x3F80; const bf16x8 ones = {one, one, one, one, one, one, one, one};
    bf16x8 kf[2][4]; u32x4 vv[2][4];
    const size_t sstep = (size_t)(32 * dil) * kvpitch;
    const unsigned short* kp0 = Kb + (ptrdiff_t)(ktok0 + dil * r32) * kvpitch + 8 * hi;
    const unsigned short* vp0 = Vb + (ptrdiff_t)(ktok0 + dil * (ln_ >> 2)) * kvpitch + (ln_ & 3) * 8;
    const unsigned short* vp1 = vp0 + (size_t)(16 * dil) * kvpitch;
    const unsigned short* kpr = kp0; const unsigned short* vpr0 = vp0; const unsigned short* vpr1 = vp1;
#define BAND_LOAD(s_, b_) do { if (EDGE) { \
        int tk_ = ktok0 + dil * (32 * (s_) + r32); tk_ = tk_ < 0 ? 0 : (tk_ > SEQ - 1 ? SEQ - 1 : tk_); \
        const unsigned short* kp_ = Kb + (size_t)tk_ * kvpitch + 8 * hi; \
        _Pragma("unroll") for (int d0 = 0; d0 < 4; ++d0) kf[b_][d0] = *(const bf16x8*)(kp_ + 16 * d0); \
        _Pragma("unroll") for (int pc = 0; pc < 4; ++pc) { int tv_ = ktok0 + dil * (32 * (s_) + 16 * (pc & 1) + (ln_ >> 2)); tv_ = tv_ < 0 ? 0 : (tv_ > SEQ - 1 ? SEQ - 1 : tv_); \
            vv[b_][pc] = *(const u32x4*)(Vb + (size_t)tv_ * kvpitch + (pc >> 1) * 32 + (ln_ & 3) * 8); } \
      } else { const unsigned short* kp_ = kpr; const unsigned short* va_ = vpr0; const unsigned short* vb_ = vpr1; kpr += sstep; vpr0 += sstep; vpr1 += sstep; asm volatile("" : "+v"(kpr), "+v"(vpr0), "+v"(vpr1)); \
        _Pragma("unroll") for (int d0 = 0; d0 < 4; ++d0) kf[b_][d0] = *(const bf16x8*)(kp_ + 16 * d0); \
        vv[b_][0] = *(const u32x4*)(va_); vv[b_][2] = *(const u32x4*)(va_ + 32); vv[b_][1] = *(const u32x4*)(vb_); vv[b_][3] = *(const u32x4*)(vb_ + 32); } } while (0)
    BAND_LOAD(0, 0);
    const float fq = (float)(4 * hi - HALFW - r32);
#pragma unroll
    for (int s = 0; s < NSUB; ++s) {
        const int cur = s & 1;
        float fqs = fq; int r32s = r32; asm volatile("" : "+v"(fqs), "+v"(r32s));
        if (s + 1 < NSUB) BAND_LOAD(s + 1, cur ^ 1);
        asm volatile("" ::: "memory");
#pragma unroll
        for (int pc = 0; pc < 4; ++pc) *(LAS u32x4*)(vst + pc * 1024 + ln_ * 16) = vv[cur][pc];
        f32x16 p;
        if (s == SMID) {
#pragma unroll
            for (int r = 0; r < 16; ++r) p[r] = __builtin_fmaf(-slope2d, __builtin_fabsf(fqs + (float)(32 * s + (r & 3) + 8 * (r >> 2))), negM);
        } else {
            float sl = s < SMID ? slope2d : -slope2d; asm volatile("" : "+v"(sl)); const float pb = __builtin_fmaf(sl, fqs, negM);
#pragma unroll
            for (int r = 0; r < 16; ++r) p[r] = __builtin_fmaf(sl, (float)(32 * s + (r & 3) + 8 * (r >> 2)), pb);
        }
#pragma unroll
        for (int d0 = 0; d0 < 4; ++d0) p = MFMA32(kf[cur][d0], qf[d0], p);
        if (s == 0) {
#pragma unroll
            for (int r = 0; r < 16; ++r) if (crow(r, hi) < r32s) p[r] = -INFINITY;
        }
        if (s == NSUB - 1) {
#pragma unroll
            for (int r = 0; r < 16; ++r) if (crow(r, hi) > r32s) p[r] = -INFINITY;
        }
        if (EDGE) {
#pragma unroll
            for (int r = 0; r < 16; ++r) { const int tok = ktok0 + dil * (32 * s + crow(r, hi)); if (tok < 0 || tok >= SEQ) p[r] = -INFINITY; }
        }
#pragma unroll
        for (int r = 0; r < 16; ++r) p[r] = __builtin_amdgcn_exp2f(p[r]);
        u32x4 w0, w1;
        w0.x = cvtpk(p[0], p[1]); w0.y = cvtpk(p[2], p[3]); w0.z = cvtpk(p[4], p[5]); w0.w = cvtpk(p[6], p[7]);
        w1.x = cvtpk(p[8], p[9]); w1.y = cvtpk(p[10], p[11]); w1.z = cvtpk(p[12], p[13]); w1.w = cvtpk(p[14], p[15]);
        const bf16x8 pa0 = __builtin_bit_cast(bf16x8, w0), pa1 = __builtin_bit_cast(bf16x8, w1);
        asm volatile("" ::: "memory");
#pragma unroll
        for (int s2 = 0; s2 < 2; ++s2)
#pragma unroll
            for (int d0 = 0; d0 < 2; ++d0) { const s16x4 lo4 = vtr(vrd + d0 * 2048 + s2 * 1024), hi4 = vtr(vrd + d0 * 2048 + s2 * 1024 + 512);
                const bf16x8 vb = {lo4[0], lo4[1], lo4[2], lo4[3], hi4[0], hi4[1], hi4[2], hi4[3]};
                o[d0] = MFMA32(s2 ? pa1 : pa0, vb, o[d0]); }
        lsum = MFMA32(pa0, ones, lsum); lsum = MFMA32(pa1, ones, lsum);
        asm volatile("" ::: "memory");
    }
#undef BAND_LOAD
}
template <int NSUB>
DI void band_run(f32x16 (&o)[2], f32x16& lsum, const bf16x8 (&qf)[4], const unsigned short* Kb, const unsigned short* Vb, const int kvpitch,
                 const int ktok0, const int dil, const float slope2d, const float negM, LAS unsigned char* vst, const int lane) {
    const bool edge = (ktok0 < 0) || (ktok0 + dil * (32 * NSUB - 1) >= SEQ);
    if (edge) band_run_t<NSUB, true>(o, lsum, qf, Kb, Vb, kvpitch, ktok0, dil, slope2d, negM, vst, lane);
    else band_run_t<NSUB, false>(o, lsum, qf, Kb, Vb, kvpitch, ktok0, dil, slope2d, negM, vst, lane);
}
DI void part_store(const f32x16 (&o)[2], const f32x16& lsum, LAS unsigned short* ptab, LAS float* ltab, int a, int st, int lane) {
    int ln_ = lane; asm volatile("" : "+v"(ln_)); const int r32 = ln_ & 31, hi = ln_ >> 5;
#pragma unroll
    for (int r = 0; r < 16; ++r) { const int idx = a + st * crow(r, hi); ptab[idx * 64 + r32] = (unsigned short)f2bf(o[0][r]); ptab[idx * 64 + 32 + r32] = (unsigned short)f2bf(o[1][r]); if (r32 == 0) ltab[idx] = lsum[r]; }
}
DI void part_load(f32x16 (&o)[2], f32x16& lsum, const LAS unsigned short* ptab, const LAS float* ltab, int a, int st, int lane) {
    int ln_ = lane; asm volatile("" : "+v"(ln_)); const int r32 = ln_ & 31, hi = ln_ >> 5;
#pragma unroll
    for (int r = 0; r < 16; ++r) { const int idx = a + st * crow(r, hi); o[0][r] = bf2f(ptab[idx * 64 + r32]); o[1][r] = bf2f(ptab[idx * 64 + 32 + r32]); lsum[r] = ltab[idx]; }
}
DI void store_o_rows(const f32x16 (&o)[2], const f32x16& lsum, float lextra, unsigned short* Orow0, int opitch, LAS unsigned char* vst, int lane) {
    int ln_ = lane; asm volatile("" : "+v"(ln_)); const int r32 = ln_ & 31, hi = ln_ >> 5; LAS unsigned short* stg = (LAS unsigned short*)vst;
    asm volatile("" ::: "memory");
#pragma unroll
    for (int r = 0; r < 16; ++r) { const float inv = 1.0f / (lsum[r] + lextra); const int q = crow(r, hi); stg[q * 64 + r32] = (unsigned short)f2bf(o[0][r] * inv); stg[q * 64 + 32 + r32] = (unsigned short)f2bf(o[1][r] * inv); }
    asm volatile("s_waitcnt lgkmcnt(0)" ::: "memory");
#pragma unroll
    for (int i = 0; i < 4; ++i) { const int row = i * 8 + (ln_ >> 3), ch = ln_ & 7; const u32x4 v = *(const LAS u32x4*)(stg + row * 64 + ch * 8); *(u32x4*)(Orow0 + (size_t)row * opitch + ch * 8) = v; }
    asm volatile("s_waitcnt lgkmcnt(0)" ::: "memory");
}
}

DI void p_attn_l0(Frame& F) {
    using namespace att;
    const int lane = F.lane, r32 = lane & 31, hi = lane >> 5, wave = F.wave;
    LAS unsigned char* vst = F.lds + RING_OFF + wave * 4096;
    LAS unsigned short* ptab = (LAS unsigned short*)(F.lds + RING_OFF + 32768);
    LAS float* ltab = (LAS float*)(F.lds + RING_OFF + 98304);
    LAS float* scr = (LAS float*)(F.lds + RING_OFF + 32768 + wave * 8704);
    const float* cst = (const float*)(F.ws + WS_CONST);
    const unsigned short* QAB = (const unsigned short*)(F.ws + WS_QAB); const unsigned short* KA = (const unsigned short*)(F.ws + WS_KA); const unsigned short* VA = (const unsigned short*)(F.ws + WS_VA);
    const unsigned short* KVB = (const unsigned short*)(F.ws + WS_KVB); unsigned short* O0 = (unsigned short*)(F.ws + WS_O0);
    const int NGW = F.G * NWAVES; int wit = F.vcu * NWAVES + wave;
    for (int unit = F.vcu; unit < 256; unit += F.G) {
        const int span = unit & 15, h = (unit >> 4) & 7, b = unit >> 7, base = span * 512; const size_t rb = (size_t)b * SEQ;
        f32x16 o[2], lsum; bf16x8 qf[4];
        for (int rpa_ = 0; rpa_ < (DBG_REPEAT_PHASE == 31 ? 2 : 1); ++rpa_)
        {
            const unsigned short* Qh = QAB + rb * 1024 + h * 64; const unsigned short* Kh = KA + rb * 512 + h * 64; const unsigned short* Vh = VA + rb * 512 + h * 64;
            const float slope2 = exp2f(-0.5f * (float)(2 * h + 1)) * LOG2E, negM = -cst[0];
#pragma unroll 1
            for (int pass = 0; pass < 3; ++pass) {
                const int dil = pass == 0 ? 16 : (pass == 1 ? 4 : 1);
#pragma unroll 1
                for (int task = wave; task < 16; task += NWAVES) {
                    const int a = pass == 0 ? task : (pass == 1 ? (task & 3) + 128 * (task >> 2) : 32 * task);
                    load_q(qf, Qh, 1024, base + a + dil * r32, hi);
                    if (pass == 0) {
#pragma unroll
                        for (int r = 0; r < 16; ++r) { o[0][r] = 0.f; o[1][r] = 0.f; lsum[r] = 0.f; }
                    } else part_load(o, lsum, ptab, ltab, a, dil, lane);
                    band_run<5>(o, lsum, qf, Kh, Vh, 512, base + a - 64 * dil, dil, slope2 * (float)dil, negM, vst, lane);
                    if (pass < 2) part_store(o, lsum, ptab, ltab, a, dil, lane);
                    else store_o_rows(o, lsum, 0.f, O0 + (rb + base + a) * 1024 + h * 64, 1024, vst, lane);
                }
                if (pass < 2) __syncthreads();
            }
            __syncthreads();
        }
        for (int rpb_ = 0; rpb_ < (DBG_REPEAT_PHASE == 32 ? 2 : 1); ++rpb_)
        {
            const unsigned short* Qh = QAB + rb * 1024 + 512 + h * 64; const unsigned short* Kh = KVB + rb * 256 + (h >> 2) * 64; const unsigned short* Vh = KVB + rb * 256 + 128 + (h >> 2) * 64;
            const float Mh = cst[1 + h], slope2 = exp2f(-(float)(h + 1)) * LOG2E, lextra = exp2f(F.a->in[I_BSINK][h] * LOG2E - Mh);
            for (int task = wave; task < 16; task += NWAVES) {
                if (wave < 4) for (int n = 0; n < 3 && wit < MOE_WITEMS; ++n, wit += NGW) moe_weight_item(F, witem_of_layer(0, wit), scr);
                const int a = 32 * task;
                load_q(qf, Qh, 1024, base + a + r32, hi);
#pragma unroll
                for (int r = 0; r < 16; ++r) { o[0][r] = 0.f; o[1][r] = 0.f; lsum[r] = 0.f; }
                band_run<9>(o, lsum, qf, Kh, Vh, 256, base + a - 128, 1, slope2, -Mh, vst, lane);
                store_o_rows(o, lsum, lextra, O0 + (rb + base + a) * 1024 + 512 + h * 64, 1024, vst, lane);
                if (wave >= 4) for (int n = 0; n < 3 && wit < MOE_WITEMS; ++n, wit += NGW) moe_weight_item(F, witem_of_layer(0, wit), scr);
            }
            __syncthreads();
        }
    }
    for (; wit < MOE_WITEMS; wit += NGW) moe_weight_item(F, witem_of_layer(0, wit), scr);
}
struct Route { int e0, e1, pos0, pos1; float w0, w1; int pad0, pad1; };
DI void p_route(Frame& F, int layer) {
    const int gw = F.vcu * NWAVES + F.wave, NGW = F.G * NWAVES, lane = F.lane;
    const float* gb = F.a->in[I_MGB] + layer * 4; const float* eb = F.a->in[I_MEB] + layer * 32;
    const GAS f32x4* gtab = (const GAS f32x4*)(F.ws + WS_CONST + 65536) + (size_t)layer * 9216 + lane; const GAS f32x4* etab = gtab + 1024;
    Route* route = (Route*)(F.ws + WS_ROUTE);
    LAS f32x4* etl = (LAS f32x4*)(F.lds + RING_OFF);
    f32x4 vfirst[4]; if (gw < M) load_row16(F.out + (size_t)gw * D, lane, vfirst);
    { const GAS f32x4* src = etab - lane;
#pragma unroll
      for (int i = 0; i < 16; ++i) etl[F.tid + 512 * i] = src[F.tid + 512 * i]; }
    LAS int* lcnt = (LAS int*)(F.lds + LDSCTL_OFF + 1280); LAS int* lbase = (LAS int*)(F.lds + LDSCTL_OFF + 1408);
    if (F.tid < 32) lcnt[F.tid] = 0;
    const bool agg = (M + NGW - 1) / NGW <= 64;
    f32x4 gt[16], gg[4];
#pragma unroll
    for (int i = 0; i < 16; ++i) gt[i] = gtab[i * 64];
    { const GAS f32x4* gr = (const GAS f32x4*)(F.a->in[I_FFNN] + layer * D) + lane;
#pragma unroll
      for (int j = 0; j < 4; ++j) gg[j] = gr[64 * j]; }
    __syncthreads();
    for (int dbgrep = ((layer == 0 ? 5 : 14) == DBG_REPEAT_PHASE ? 0 : 1); dbgrep < 2; ++dbgrep) {
    int myE0 = 0, myE1 = 0, myM = -1; float myW0 = 0.f, myW1 = 0.f; int jrow = 0;
    f32x4 v[4], vn[4];
#pragma unroll
    for (int j = 0; j < 4; ++j) vn[j] = vfirst[j];
    for (int m = gw; m < M; m += NGW, ++jrow) {
#pragma unroll
        for (int j = 0; j < 4; ++j) v[j] = vn[j];
        if (m + NGW < M) load_row16(F.out + (size_t)(m + NGW) * D, lane, vn);
        const float rinv = row_rinv(v);
        row_norm_store_g(v, rinv, gg, (bf16*)(F.ws + WS_XN) + (size_t)m * D, lane);
        float g0 = 0.f, g1 = 0.f, g2 = 0.f, g3 = 0.f;
#pragma unroll
        for (int j = 0; j < 4; ++j) {
#pragma unroll
            for (int c = 0; c < 4; ++c) { const f32x4 w = gt[4 * j + c]; const float hv = v[j][c]; g0 += hv * w.x; g1 += hv * w.y; g2 += hv * w.z; g3 += hv * w.w; } }
        g0 = wave_sum(g0) + gb[0]; g1 = wave_sum(g1) + gb[1]; g2 = wave_sum(g2) + gb[2]; g3 = wave_sum(g3) + gb[3];
        int gi = 0; float gm = g0; if (g1 > gm) { gm = g1; gi = 1; } if (g2 > gm) { gm = g2; gi = 2; } if (g3 > gm) { gm = g3; gi = 3; }
        const float pgrp = 1.0f / (expf(g0 - gm) + expf(g1 - gm) + expf(g2 - gm) + expf(g3 - gm));
        gi = __builtin_amdgcn_readfirstlane(gi);
        float e[8];
#pragma unroll
        for (int k = 0; k < 8; ++k) e[k] = 0.f;
        const LAS f32x4* ew = etl + gi * 2048 + lane;
#pragma unroll
        for (int j = 0; j < 4; ++j) {
#pragma unroll
            for (int c = 0; c < 4; ++c) { const f32x4 wa = ew[((4 * j + c) * 2) * 64], wb = ew[((4 * j + c) * 2 + 1) * 64]; const float hv = v[j][c];
                e[0] += hv * wa.x; e[1] += hv * wa.y; e[2] += hv * wa.z; e[3] += hv * wa.w; e[4] += hv * wb.x; e[5] += hv * wb.y; e[6] += hv * wb.z; e[7] += hv * wb.w; } }
#pragma unroll
        for (int k = 0; k < 8; ++k) e[k] = wave_sum(e[k]) + eb[gi * 8 + k];
        int i0 = 0; float m0 = e[0];
#pragma unroll
        for (int k = 1; k < 8; ++k) if (e[k] > m0) { m0 = e[k]; i0 = k; }
        int i1 = -1; float m1 = -INFINITY;
#pragma unroll
        for (int k = 0; k < 8; ++k) if (k != i0 && e[k] > m1) { m1 = e[k]; i1 = k; }
        const float t = expf(m1 - m0); const float w0 = pgrp / (1.0f + t), w1 = pgrp * t / (1.0f + t);
        if (lane == (jrow & 63)) { myE0 = gi * 8 + i0; myE1 = gi * 8 + i1; myW0 = w0; myW1 = w1; myM = m; }
#define ROUTE_EMIT(p0_, p1_) do { Route r; r.e0 = myE0; r.e1 = myE1; r.pos0 = (p0_); r.pos1 = (p1_); r.w0 = myW0; r.w1 = myW1; r.pad0 = 0; r.pad1 = 0; route[myM] = r; \
            int* list = (int*)(F.ws + WS_LIST); float* listw = (float*)(F.ws + WS_LIST + 2 * MiB); \
            list[(size_t)myE0 * M + (p0_)] = myM; listw[(size_t)myE0 * M + (p0_)] = myW0; list[(size_t)myE1 * M + (p1_)] = myM; listw[(size_t)myE1 * M + (p1_)] = myW1; } while (0)
        if (!agg && ((jrow & 63) == 63 || m + NGW >= M)) {
            if (myM >= 0 && dbgrep == 1) {
                const int p0 = (int)__hip_atomic_fetch_add(F.ctl + CW_CNT + (layer * 32 + myE0) * 64, 1u, RLX_AGENT);
                const int p1 = (int)__hip_atomic_fetch_add(F.ctl + CW_CNT + (layer * 32 + myE1) * 64, 1u, RLX_AGENT);
                ROUTE_EMIT(p0, p1);
            }
            myM = -1;
        }
    }
    if (agg) {
        const bool live = myM >= 0 && dbgrep == 1; int r0 = 0, r1 = 0;
        if (live) { r0 = __hip_atomic_fetch_add(lcnt + myE0, 1, __ATOMIC_RELAXED, __HIP_MEMORY_SCOPE_WORKGROUP); r1 = __hip_atomic_fetch_add(lcnt + myE1, 1, __ATOMIC_RELAXED, __HIP_MEMORY_SCOPE_WORKGROUP); }
        __syncthreads();
        if (F.tid < 32) { const int c = lcnt[F.tid]; lbase[F.tid] = c > 0 ? (int)__hip_atomic_fetch_add(F.ctl + CW_CNT + (layer * 32 + F.tid) * 64, (unsigned)c, RLX_AGENT) : 0; }
        __syncthreads();
        if (live) { const int p0 = lbase[myE0] + r0, p1 = lbase[myE1] + r1; ROUTE_EMIT(p0, p1); }
        if (F.tid < 32) lcnt[F.tid] = 0;
        __syncthreads();
    }
#undef ROUTE_EMIT
    }
}
DI void build_tables(Frame& F, int layer) {
    LAS int* tstart = (LAS int*)(F.lds + LDSCTL_OFF + 1024); LAS int* tmp = (LAS int*)(F.lds + LDSCTL_OFF + 1280); LAS int* tab = (LAS int*)(F.lds + LDSCTL_OFF + 2048);
    __syncthreads();
    if (F.tid < 32) { const int cnt = (int)__hip_atomic_load(F.ctl + CW_CNT + (layer * 32 + F.tid) * 64, RLX_AGENT); tmp[F.tid] = (cnt + 255) >> 8; ((LAS int*)(F.lds + LDSCTL_OFF + 1408))[F.tid] = cnt; }
    __syncthreads();
    if (F.tid < 32) { const int e = F.tid; int acc = 0;
#pragma unroll
        for (int k = 0; k < 32; ++k) { const int t = tmp[k]; acc += k < e ? t : 0; }
        tstart[e] = acc; const int n = tmp[e]; for (int t = 0; t < n; ++t) tab[1 + acc + t] = e; if (e == 31) { tstart[32] = acc + n; tab[0] = acc + n; } }
    __syncthreads();
}
template <class Sched> DI void moe_rowtab(Frame& F, const Sched& S, LAS int* rowtab, LAS float* wtab) {
    const LAS int* tstart = (const LAS int*)(F.lds + LDSCTL_OFF + 1024); const LAS int* cnts = (const LAS int*)(F.lds + LDSCTL_OFF + 1408); const LAS int* tab = (const LAS int*)(F.lds + LDSCTL_OFF + 2048);
    const int* list = (const int*)(F.ws + WS_LIST); const float* listw = (const float*)(F.ws + WS_LIST + 2 * MiB);
    const int i = F.tid >> 8, r = F.tid & 255; pg8::Unit u;
    if (S.next(i, u)) { const int e = tab[1 + u.pm], local = (u.pm - tstart[e]) * 256 + r; const bool ok = local < cnts[e];
        int tok = 0; float w = 0.f;
        if (ok) { tok = (int)__hip_atomic_load((const gu32*)list + (size_t)e * M + local, RLX_AGENT); w = __builtin_bit_cast(float, __hip_atomic_load((const gu32*)listw + (size_t)e * M + local, RLX_AGENT)); }
        rowtab[i * 256 + r] = tok; wtab[i * 256 + r] = w; }
    __syncthreads();
}
DI void p_combine(Frame& F, int layer, bool fin, bool tables_ready) {
    if (!tables_ready) build_tables(F, layer);
    const int gw = F.vcu * NWAVES + F.wave, NGW = F.G * NWAVES, lane = F.lane;
    const LAS int* tstart = (const LAS int*)(F.lds + LDSCTL_OFF + 1024); const Route* route = (const Route*)(F.ws + WS_ROUTE);
    const bf16* Y = (const bf16*)(F.ws + WS_XG);
    f32x4 gg[4]; { const GAS f32x4* gr = (const GAS f32x4*)(F.a->in[I_MIXN] + D) + lane;
#pragma unroll
        for (int j = 0; j < 4; ++j) gg[j] = fin ? f32x4{0.f, 0.f, 0.f, 0.f} : gr[64 * j]; }
    for (int dbgrep = ((layer == 0 ? 9 : 18) == DBG_REPEAT_PHASE ? 0 : 1); dbgrep < 2; ++dbgrep)
    for (int mb = gw; mb < M; mb += 64 * NGW) {
        int s0v = 0, s1v = 0;
        { const int mj = mb + NGW * lane;
          if (mj < M) { const gu32* rp = (const gu32*)(route + mj);
              const int e0 = (int)__hip_atomic_load(rp + 0, RLX_AGENT), e1 = (int)__hip_atomic_load(rp + 1, RLX_AGENT), q0 = (int)__hip_atomic_load(rp + 2, RLX_AGENT), q1 = (int)__hip_atomic_load(rp + 3, RLX_AGENT);
              s0v = 256 * tstart[e0] + q0; s1v = 256 * tstart[e1] + q1; } }
        f32x4 v[4], vn[4]; unsigned long long ya[4], yb[4], yan[4], ybn[4];
#define COMB_LOAD(m_, j_, X_, A_, B_) do { load_row16(F.out + (size_t)(m_) * D, lane, X_); \
            const int s0_ = __builtin_amdgcn_readlane(s0v, (j_)), s1_ = __builtin_amdgcn_readlane(s1v, (j_)); \
            const GAS unsigned long long* y0_ = (const GAS unsigned long long*)(Y + (size_t)s0_ * D) + lane; const GAS unsigned long long* y1_ = (const GAS unsigned long long*)(Y + (size_t)s1_ * D) + lane; \
            _Pragma("unroll") for (int q_ = 0; q_ < 4; ++q_) { A_[q_] = y0_[64 * q_]; B_[q_] = y1_[64 * q_]; } } while (0)
        COMB_LOAD(mb, 0, vn, yan, ybn);
        int j = 0;
        for (int m = mb; m < M && j < 64; m += NGW, ++j) {
#pragma unroll
            for (int q = 0; q < 4; ++q) { v[q] = vn[q]; ya[q] = yan[q]; yb[q] = ybn[q]; }
            if (m + NGW < M && j + 1 < 64) COMB_LOAD(m + NGW, j + 1, vn, yan, ybn);
            GAS f32x4* xo = (GAS f32x4*)(F.out + (size_t)m * D) + lane;
#pragma unroll
            for (int q = 0; q < 4; ++q) { const unsigned long long a = ya[q], b2 = yb[q];
                f32x4 add; add.x = bf2f((unsigned short)a) + bf2f((unsigned short)b2); add.y = bf2f((unsigned short)(a >> 16)) + bf2f((unsigned short)(b2 >> 16));
                add.z = bf2f((unsigned short)(a >> 32)) + bf2f((unsigned short)(b2 >> 32)); add.w = bf2f((unsigned short)(a >> 48)) + bf2f((unsigned short)(b2 >> 48));
                v[q] = v[q] + add; if (dbgrep == 1) xo[64 * q] = v[q]; }
            if (!fin && dbgrep == 1) { const float rinv = row_rinv(v); row_norm_store_g(v, rinv, gg, (bf16*)(F.ws + WS_XN) + (size_t)m * D, lane); }
        }
#undef COMB_LOAD
    }
}

__global__ void __launch_bounds__(NWAVES * 64, 2) hyb_fwd(Args args) {
    extern __shared__ __attribute__((aligned(16))) unsigned char lds[];
    Frame F;
    F.lds = (LAS unsigned char*)lds;
    F.MISC = (volatile LAS unsigned*)(F.lds + MISC_OFF);
    F.tid = threadIdx.x; F.lane = F.tid & 63; F.wave = __builtin_amdgcn_readfirstlane(F.tid >> 6);
    const int wave0 = F.wave;
    F.G = gridDim.x; { const int bx = blockIdx.x; F.vcu = (F.G % 8 == 0) ? (bx % 8) * (F.G / 8) + bx / 8 : bx; }
    F.a = (KArgs)__builtin_amdgcn_kernarg_segment_ptr(); F.ws = args.ws; F.ctl = (gu32*)(args.ws + WS_CTL); F.out = args.out;
    for (int u = F.tid; u < (LDS_BYTES - LDSCTL_OFF) / 4; u += NWAVES * 64) ((LAS unsigned*)(F.lds + LDSCTL_OFF))[u] = 0u;
    __syncthreads();
    const int lo = args.ph_lo, hi = args.ph_hi;
    XcdBarrier bar; bar.bar = (unsigned*)(F.ctl + CW_BAR); bar.x = 0; bar.st = nullptr; bar.tid = 0;
    if (hi - lo > 1) bar = xcd_barrier_post((unsigned*)(F.ctl + CW_BAR), F.MISC + 8);
#ifndef PH_EN
#define PH_EN 0x7ffff
#endif
#define IN(k) (((PH_EN >> (k)) & 1) && lo <= (k) && (k) < hi)
#ifndef DBG_REPEAT_PHASE
#define DBG_REPEAT_PHASE (-1)
#endif
#define REP(k) for (int rep_ = 0; rep_ < ((k) == DBG_REPEAT_PHASE ? 2 : 1); ++rep_)
#ifndef PROBE_PH
#define PROBE_PH (-1)
#endif
    unsigned long long tph_ = 0;
#define SEAM(k) do { if (PROBE_PH == (k)) { const unsigned long long t1_ = __builtin_amdgcn_s_memtime(); while (__builtin_amdgcn_s_memtime() - t1_ < t1_ - tph_) __builtin_amdgcn_s_sleep(8); } \
    if (IN(k) && IN((k) + 1)) { XcdBarrier b2_ = bar; b2_.tid = F.tid; asm volatile("" : "+s"(b2_.bar)); xcd_barrier(b2_); if (DBG_REPEAT_PHASE == 99) xcd_barrier(b2_); } } while (0)
    bf16* XN = (bf16*)(F.ws + WS_XN);
#define PB() do { int t_ = wave0 * 64 + (int)__lane_id(); asm volatile("" : "+v"(t_)); F.tid = t_; F.lane = t_ & 63; F.wave = __builtin_amdgcn_readfirstlane(t_ >> 6); \
        KArgs a_ = (KArgs)__builtin_amdgcn_kernarg_segment_ptr(); asm volatile("" : "+s"(a_)); F.a = a_; F.ws = a_->ws; F.ctl = (gu32*)(a_->ws + WS_CTL); F.out = a_->out; XN = (bf16*)(F.ws + WS_XN); } while (0)

    if (IN(0)) { PB(); if (PROBE_PH >= 0) tph_ = __builtin_amdgcn_s_memtime(); REP(0) p_prologue(F); SEAM(0); }
    if (IN(1)) { PB(); if (PROBE_PH >= 0) tph_ = __builtin_amdgcn_s_memtime();
        pg8::Gemm g{XN, (const bf16*)(F.ws + WS_WABIN), M, AB_PROJ, D}; pg8::StaticOrder S; S.init(M, AB_PROJ, F.G, (int)blockIdx.x);
        pg8::EpiQKV0 E{F.ws, F.a->in[I_AQN], F.a->in[I_AKN], F.a->in[I_BQN], F.a->in[I_BKN], nullptr, C2, RMS_EPS};
        REP(1) pg8::gemm_phase<pg8::EpiQKV0, pg8::StaticOrder, PG8_ALIGN, PG8_SP2>(F.lds + RING_OFF, g, S, E, F.tid);
        SEAM(1);
    }
    if (IN(3)) { PB(); if (PROBE_PH >= 0) tph_ = __builtin_amdgcn_s_memtime(); REP(3) p_attn_l0(F); SEAM(3); }
    if (IN(4)) { PB(); if (PROBE_PH >= 0) tph_ = __builtin_amdgcn_s_memtime();
        pg8::Gemm g{(const bf16*)(F.ws + WS_O0), (const bf16*)(F.ws + WS_WABOUT), M, D, D}; pg8::StaticOrder S; S.init(M, D, F.G, (int)blockIdx.x);
        pg8::EpiResid E{F.a->in[I_X], F.out, D};
        REP(4) pg8::gemm_phase<pg8::EpiResid, pg8::StaticOrder, PG8_ALIGN, PG8_SP2>(F.lds + RING_OFF, g, S, E, F.tid);
        SEAM(4);
    }
#define MOE_BLOCK(layer, pb) do { \
        if (IN(pb)) { PB(); if (PROBE_PH >= 0) tph_ = __builtin_amdgcn_s_memtime(); p_route(F, layer); SEAM(pb); } \
        if (IN((pb) + 2)) { PB(); if (PROBE_PH >= 0) tph_ = __builtin_amdgcn_s_memtime(); \
            build_tables(F, layer); const LAS int* tab = (const LAS int*)(F.lds + LDSCTL_OFF + 2048); \
            const int T_ = __builtin_amdgcn_readfirstlane(tab[0]); \
            unsigned* ready = (unsigned*)(F.ctl + CW_RDY) + (size_t)(layer) * 160 * 64; \
            const int a_ = (2 * T_ > F.G && T_ <= F.G) ? 2 * T_ - F.G : 0;     \
            {     \
                pg8::Gemm g{XN, (const bf16*)(F.ws + WS_WGU) + (size_t)(layer) * (32 * 512 * 1024), M, 32 * 512, D}; \
                pg8::MoeOrderA S{tab, T_, a_, F.vcu}; \
                LAS int* rowtab = (LAS int*)(F.lds + LDSCTL_OFF + 4096); LAS float* wtab = (LAS float*)(F.lds + LDSCTL_OFF + 4096 + 2048); \
                moe_rowtab(F, S, rowtab, wtab); \
                pg8::EpiSwiGLU E{(bf16*)(F.ws + WS_A2), wtab}; \
                pg8::gemm_phase<pg8::EpiSwiGLU, pg8::MoeOrderA, PG8_ALIGN, PG8_SP2, true>(F.lds + RING_OFF, g, S, E, F.tid, rowtab); \
                  \
                asm volatile("s_waitcnt vmcnt(0)" ::: "memory"); __syncthreads(); \
                if (F.tid == 0) {     \
                    pg8::Unit u_; for (int i_ = 0; S.next(i_, u_); ++i_) __hip_atomic_fetch_add(ready + 64 * u_.pm, 1u, RLX_AGENT); } \
            } \
            PB(); \
            {     \
                const LAS int* tab = (const LAS int*)(F.lds + LDSCTL_OFF + 2048); unsigned* ready = (unsigned*)(F.ctl + CW_RDY) + (size_t)(layer) * 160 * 64; \
                pg8::Gemm g{(const bf16*)(F.ws + WS_A2), (const bf16*)(F.ws + WS_WD) + (size_t)(layer) * (32 * 1024 * 256), SLOT_CAP, 32 * 1024, DFF}; \
                const int c_ = F.vcu, early_ = 4 * (T_ - a_), late_ = 4 * a_, Lw_ = F.G - a_, li_ = c_ - a_; \
                const int ne_ = __builtin_amdgcn_readfirstlane((c_ >= a_ && li_ < early_) ? (early_ - li_ + Lw_ - 1) / Lw_ : 0);     \
                pg8::MoeOrder2 S{tab, __builtin_amdgcn_readfirstlane(early_), __builtin_amdgcn_readfirstlane(li_), __builtin_amdgcn_readfirstlane(Lw_), ne_, __builtin_amdgcn_readfirstlane(c_ < late_ ? early_ + c_ : -1), wave0, ready}; \
                pg8::EpiBf16Dst<pg8::ResY> E{pg8::ResY{(bf16*)(F.ws + WS_XG)}}; \
                pg8::gemm_phase<pg8::EpiBf16Dst<pg8::ResY>, pg8::MoeOrder2, false, PG8_SP2>(F.lds + RING_OFF, g, S, E, F.tid); \
            } \
            SEAM((pb) + 3); } \
        if (IN((pb) + 4)) { PB(); if (PROBE_PH >= 0) tph_ = __builtin_amdgcn_s_memtime(); p_combine(F, layer, (layer) == 1, IN((pb) + 2)); SEAM((pb) + 4); } } while (0)
    MOE_BLOCK(0, 5);
    if (IN(10)) { PB(); if (PROBE_PH >= 0) tph_ = __builtin_amdgcn_s_memtime();
        pg8::Gemm g{XN, (const bf16*)(F.ws + WS_WCIN), M, C_PROJ, D}; pg8::StaticOrder S; S.init(M, C_PROJ, F.G, (int)blockIdx.x);
        { const GAS f32x4* src = (const GAS f32x4*)((const float*)(F.ws + WS_CONST) + 1024); LAS f32x4* dst = (LAS f32x4*)(F.lds + ROPE_LDS_OFF);
#pragma unroll
          for (int i = 0; i < 3; ++i) dst[F.tid + 512 * i] = src[F.tid + 512 * i]; }
        __syncthreads();
        pg8::EpiQKV1 E{F.ws, F.a->in[I_CQN], F.a->in[I_CKN], nullptr, nullptr, (const LAS float*)(F.lds + ROPE_LDS_OFF), C2, RMS_EPS};
        REP(10) pg8::gemm_phase<pg8::EpiQKV1, pg8::StaticOrder, PG8_ALIGN, PG8_SP2>(F.lds + RING_OFF, g, S, E, F.tid);
        SEAM(10);
    }
    if (IN(12)) { PB(); if (PROBE_PH >= 0) tph_ = __builtin_amdgcn_s_memtime();
        {
            const attn_body::AttnTensors AT{(const attn_body::bf16*)(F.ws + WS_Q1), (const attn_body::bf16*)(F.ws + WS_K1), (const attn_body::bf16*)(F.ws + WS_V1), (attn_body::bf16*)(F.ws + WS_O1), ((const float*)(F.ws + WS_CONST))[9]};
            const attn_body::StaticOrder S((int)F.G, (int)blockIdx.x);
            REP(12) { attn_body::AttnUnit u;
                LAS float* scr_ = (LAS float*)(F.lds + RING_OFF + 86016 + F.wave * WH_SCR_BYTES);
                DenseWStream hk{&F, __builtin_amdgcn_readfirstlane(F.vcu * NWAVES + F.wave), F.G * NWAVES, 0, 0, scr_, (unsigned)__builtin_amdgcn_readfirstlane((int)(unsigned)(uintptr_t)scr_)};
                for (int i = 0; S.next(i, u); ++i) { int t_ = F.tid; asm volatile("" : "+v"(t_));
                    attn_body::attn_unit<8, DenseWStream>(u.bh / attn_body::NHEAD, u.bh % attn_body::NHEAD, u.qb, AT.Q, AT.K, AT.V, AT.O, (char*)lds + RING_OFF, t_, AT.Mref, hk); }
                for (; hk.j < WSUB_L; hk.j += hk.stride) { const WHalf wd = moe_weight_half(F, wsub_of_layer(1, hk.j)); wh_issue(wd, F.lane, hk.scr_lds); asm volatile("s_waitcnt vmcnt(0)" ::: "memory"); wh_finish(wd, F.lane, scr_); }
            }
        }
        SEAM(12); }
    if (IN(13)) { PB(); if (PROBE_PH >= 0) tph_ = __builtin_amdgcn_s_memtime();
        pg8::Gemm g{(const bf16*)(F.ws + WS_O1), (const bf16*)(F.ws + WS_WCOUT), M, D, D}; pg8::StaticOrder S; S.init(M, D, F.G, (int)blockIdx.x);
        pg8::EpiResid E{F.out, F.out, D};
        pg8::gemm_phase<pg8::EpiResid, pg8::StaticOrder, PG8_ALIGN, PG8_SP2>(F.lds + RING_OFF, g, S, E, F.tid);
        SEAM(13);
    }
    MOE_BLOCK(1, 14);
#undef IN
#undef SEAM
}

extern "C" void kernel_launch(void* const* d_in, const int* in_sizes, int n_in, void* d_out, int out_size, void* d_ws, size_t ws_size, hipStream_t stream) {
    static int grid = 0;
    if (grid == 0) {
        if (n_in != 21 || in_sizes[0] != M * D || out_size != M * D || ws_size < WS_END) { fprintf(stderr, "kernel_launch: unexpected shapes (n_in %d, in0 %d, out %d, ws %zu; need ws >= %zu); nothing launched\n", n_in, n_in > 0 ? in_sizes[0] : -1, out_size, ws_size, (size_t)WS_END); grid = -1; return; }
        int dev = 0, cus = 0, per_cu = 0;
        if (hipGetDevice(&dev) != hipSuccess || hipDeviceGetAttribute(&cus, hipDeviceAttributeMultiprocessorCount, dev) != hipSuccess) { grid = -1; return; }
        if (hipFuncSetAttribute((const void*)hyb_fwd, hipFuncAttributeMaxDynamicSharedMemorySize, LDS_BYTES) != hipSuccess) { fprintf(stderr, "kernel_launch: hipFuncSetAttribute failed\n"); grid = -1; return; }
        if (hipOccupancyMaxActiveBlocksPerMultiprocessor(&per_cu, (const void*)hyb_fwd, NWAVES * 64, LDS_BYTES) != hipSuccess || per_cu < 1) { fprintf(stderr, "kernel_launch: occupancy query reports %d workgroups per CU\n", per_cu); (void)hipGetLastError(); grid = -1; return; }
        grid = cus;
    }
    if (grid < 0) return;
    (void)hipMemsetAsync((char*)d_ws + WS_CTL, 0, CTL_ZERO_BYTES, stream);
    Args a{};
    for (int i = 0; i < 21; ++i) a.in[i] = (const float*)d_in[i];
    a.out = (float*)d_out; a.ws = (unsigned char*)d_ws;
#if MK_N_LAUNCHES == 1
    a.ph_lo = 0; a.ph_hi = NPHASE;
    hipLaunchKernelGGL(hyb_fwd, dim3(grid), dim3(NWAVES * 64), LDS_BYTES, stream, a);
#else
#ifndef DBG_LAST_PHASE
#define DBG_LAST_PHASE (NPHASE - 1)
#endif
    if (DBG_LAST_PHASE < 4) (void)hipMemcpyAsync(d_out, d_in[0], (size_t)M * D * 4, hipMemcpyDeviceToDevice, stream);
    for (int p = 0; p <= DBG_LAST_PHASE; ++p) { a.ph_lo = p; a.ph_hi = p + 1; hipLaunchKernelGGL(hyb_fwd, dim3(grid), dim3(NWAVES * 64), LDS_BYTES, stream, a); }
#endif
}
```
